# Optimizing an MI355X kernel written in HIP

```python
import math
import jax, jax.numpy as jnp
from jax import lax
import numpy as np

D_MODEL = 4096
BATCH = 2
SEQ = 8192
DEPTH = 1

HEAD_DIM = 128
N_DIFF_HEADS = D_MODEL // 512
ATTN_QK = N_DIFF_HEADS * 2 * HEAD_DIM
ATTN_V = N_DIFF_HEADS * 2 * HEAD_DIM
ROT_DIM = HEAD_DIM // 4
ROPE_THETA = 500000.0
Q_BLOCK = 128
FOURIER_WIDTH = D_MODEL // 2
FOURIER_GROUP = 256
N_FOURIER_GROUPS = FOURIER_WIDTH // FOURIER_GROUP
IN_COLS = 2 * ATTN_QK + ATTN_V + FOURIER_WIDTH
D_FF = ((8 * D_MODEL // 3 + 255) // 256) * 256
CONV_WIDTH = 3
ALPHA = (2.0 * DEPTH) ** 0.25
BETA = (8.0 * DEPTH) ** -0.25
LN_EPS = 1e-5

kernel_name = 'hybrid_diffattn_fnet_convffn_deepnorm'


def layer_norm(x, g, b):
    xf = x.astype(jnp.float32)
    mu = jnp.mean(xf, axis=-1, keepdims=True)
    var = jnp.mean(jnp.square(xf - mu), axis=-1, keepdims=True)
    return ((xf - mu) * lax.rsqrt(var + LN_EPS) * g.astype(jnp.float32) + b.astype(jnp.float32)).astype(x.dtype)


def rms_norm(x, g):
    xf = x.astype(jnp.float32)
    ms = jnp.mean(jnp.square(xf), axis=-1, keepdims=True)
    return (xf * lax.rsqrt(ms + LN_EPS) * g.astype(jnp.float32)).astype(x.dtype)


def partial_rotary(t):
    s = t.shape[1]
    inv_freq = ROPE_THETA ** (-jnp.arange(0, ROT_DIM, 2, dtype=jnp.float32) / ROT_DIM)
    ang = jnp.arange(s, dtype=jnp.float32)[:, None] * inv_freq[None, :]
    cos = jnp.cos(ang).astype(t.dtype)[None, :, None, None, :]
    sin = jnp.sin(ang).astype(t.dtype)[None, :, None, None, :]
    half = ROT_DIM // 2
    x1 = t[..., :half]
    x2 = t[..., half:ROT_DIM]
    return jnp.concatenate([x1 * cos - x2 * sin, x2 * cos + x1 * sin, t[..., ROT_DIM:]], axis=-1)


def diff_attention(u_q, u_k, u_v, lq1, lk1, lq2, lk2, subln_g, lambda_init):
    b, s, _ = u_q.shape
    q = partial_rotary(u_q.reshape(b, s, N_DIFF_HEADS, 2, HEAD_DIM))
    k = partial_rotary(u_k.reshape(b, s, N_DIFF_HEADS, 2, HEAD_DIM))
    q = q.transpose(0, 2, 3, 1, 4) * (HEAD_DIM ** -0.5)
    k = k.transpose(0, 2, 3, 1, 4)
    v = u_v.reshape(b, s, N_DIFF_HEADS, 2 * HEAD_DIM).transpose(0, 2, 1, 3)
    lam = (jnp.exp(jnp.sum(lq1.astype(jnp.float32) * lk1.astype(jnp.float32)))
           - jnp.exp(jnp.sum(lq2.astype(jnp.float32) * lk2.astype(jnp.float32)))
           + lambda_init)

    def query_block(i):
        qb = lax.dynamic_slice_in_dim(q, i * Q_BLOCK, Q_BLOCK, axis=3)
        sc = jnp.einsum('bhcqd,bhckd->bhcqk', qb, k, preferred_element_type=jnp.float32)
        p = jax.nn.softmax(sc, axis=-1)
        a = (p[:, :, 0] - lam * p[:, :, 1]).astype(v.dtype)
        return jnp.einsum('bhqk,bhkv->bhqv', a, v)

    o = lax.map(query_block, jnp.arange(s // Q_BLOCK))
    o = o.transpose(1, 0, 3, 2, 4).reshape(b, s, N_DIFF_HEADS, 2 * HEAD_DIM)
    o = rms_norm(o, subln_g) * (1.0 - lambda_init)
    return o.reshape(b, s, ATTN_V)


def fourier_mix(u_f):
    b, s, _ = u_f.shape
    ug = u_f.astype(jnp.float32).reshape(b, s, N_FOURIER_GROUPS, FOURIER_GROUP)
    y = jnp.fft.fft2(ug, axes=(1, 3), norm='ortho').real
    return y.reshape(b, s, FOURIER_WIDTH).astype(u_f.dtype)


def hybrid_mixer(h, w_in, lq1, lk1, lq2, lk2, subln_g, w_attn_o, w_fourier, w_gate, b_gate, w_mix_out, lambda_init):
    u = h @ w_in
    u_q, u_k, u_v, u_f = jnp.split(u, [ATTN_QK, 2 * ATTN_QK, 2 * ATTN_QK + ATTN_V], axis=-1)
    y_attn = diff_attention(u_q, u_k, u_v, lq1, lk1, lq2, lk2, subln_g, lambda_init) @ w_attn_o
    y_four = fourier_mix(u_f) @ w_fourier
    g = jax.nn.sigmoid(h @ w_gate + b_gate)
    g_attn, g_four = jnp.split(g, 2, axis=-1)
    return (g_attn * y_attn + g_four * y_four) @ w_mix_out


def conv_ffn(h, w_up, conv_w, conv_b, w_down):
    a = h @ w_up
    ap = jnp.pad(a, ((0, 0), (1, 1), (0, 0)))
    c = ap[:, :-2] * conv_w[0] + ap[:, 1:-1] * conv_w[1] + ap[:, 2:] * conv_w[2] + conv_b
    gate, val = jnp.split(c, 2, axis=-1)
    return (jax.nn.silu(gate) * val) @ w_down


def setup_inputs(seed: int = 0) -> dict:
    key = jax.random.key(seed)
    ks = iter(jax.random.split(key, 32))
    L, D = DEPTH, D_MODEL

    def nrm(shape, scale):
        return jax.random.normal(next(ks), shape, jnp.float32) * scale

    x = nrm((BATCH, SEQ, D), 1.0)
    ln_emb_g = 1.0 + nrm((D,), 0.01)
    ln_emb_b = nrm((D,), 0.01)
    w_in = jnp.concatenate([
        nrm((L, D, ATTN_QK), D ** -0.5),
        nrm((L, D, ATTN_QK), D ** -0.5),
        nrm((L, D, ATTN_V), D ** -0.5 * BETA),
        nrm((L, D, FOURIER_WIDTH), D ** -0.5),
    ], axis=-1)
    lambda_q1 = nrm((L, HEAD_DIM), 0.1)
    lambda_k1 = nrm((L, HEAD_DIM), 0.1)
    lambda_q2 = nrm((L, HEAD_DIM), 0.1)
    lambda_k2 = nrm((L, HEAD_DIM), 0.1)
    subln_g = 1.0 + nrm((L, 2 * HEAD_DIM), 0.01)
    w_attn_o = nrm((L, ATTN_V, D), ATTN_V ** -0.5 * BETA)
    w_fourier = nrm((L, FOURIER_WIDTH, D), FOURIER_WIDTH ** -0.5 * BETA)
    w_gate = nrm((L, D, 2 * D), D ** -0.5)
    b_gate = nrm((L, 2 * D), 0.01)
    w_mix_out = nrm((L, D, D), D ** -0.5 * BETA)
    ln1_g = 1.0 + nrm((L, D), 0.01)
    ln1_b = nrm((L, D), 0.01)
    w_up = nrm((L, D, 2 * D_FF), D ** -0.5 * BETA)
    conv_w = nrm((L, CONV_WIDTH, 2 * D_FF), CONV_WIDTH ** -0.5)
    conv_b = nrm((L, 2 * D_FF), 0.01)
    w_down = nrm((L, D_FF, D), D_FF ** -0.5 * BETA)
    ln2_g = 1.0 + nrm((L, D), 0.01)
    ln2_b = nrm((L, D), 0.01)
    return {'x': x, 'ln_emb_g': ln_emb_g, 'ln_emb_b': ln_emb_b, 'w_in': w_in,
            'lambda_q1': lambda_q1, 'lambda_k1': lambda_k1, 'lambda_q2': lambda_q2, 'lambda_k2': lambda_k2,
            'subln_g': subln_g, 'w_attn_o': w_attn_o, 'w_fourier': w_fourier,
            'w_gate': w_gate, 'b_gate': b_gate, 'w_mix_out': w_mix_out,
            'ln1_g': ln1_g, 'ln1_b': ln1_b, 'w_up': w_up, 'conv_w': conv_w, 'conv_b': conv_b,
            'w_down': w_down, 'ln2_g': ln2_g, 'ln2_b': ln2_b}


def reference(x, ln_emb_g, ln_emb_b, w_in, lambda_q1, lambda_k1, lambda_q2, lambda_k2, subln_g,
              w_attn_o, w_fourier, w_gate, b_gate, w_mix_out, ln1_g, ln1_b,
              w_up, conv_w, conv_b, w_down, ln2_g, ln2_b):
    h = layer_norm(x, ln_emb_g, ln_emb_b)
    for l in range(DEPTH):
        lambda_init = 0.8 - 0.6 * math.exp(-0.3 * l)
        m = hybrid_mixer(h, w_in[l], lambda_q1[l], lambda_k1[l], lambda_q2[l], lambda_k2[l], subln_g[l],
                         w_attn_o[l], w_fourier[l], w_gate[l], b_gate[l], w_mix_out[l], lambda_init)
        h = layer_norm(ALPHA * h + m, ln1_g[l], ln1_b[l])
        f = conv_ffn(h, w_up[l], conv_w[l], conv_b[l], w_down[l])
        h = layer_norm(ALPHA * h + f, ln2_g[l], ln2_b[l])
    return h
```

```cpp
#include <hip/hip_runtime.h>
#include <cstdio>
#include <cstdint>
#include <cstddef>

#ifndef ATT_V256
#define ATT_V256 1
#endif
#ifndef MK_PER_PHASE
#define MK_PER_PHASE 0
#endif

#define GAS __attribute__((address_space(1)))
#define LAS __attribute__((address_space(3)))
typedef unsigned short bf16;
typedef unsigned v4u __attribute__((ext_vector_type(4)));
typedef unsigned v2u __attribute__((ext_vector_type(2)));
typedef float f32x4 __attribute__((ext_vector_type(4)));
typedef _Float16 h16x4 __attribute__((ext_vector_type(4)));
typedef _Float16 h16x8 __attribute__((ext_vector_type(8)));
typedef float f32x2 __attribute__((ext_vector_type(2)));
typedef short bf16x8 __attribute__((ext_vector_type(8)));
#define LDS_WAIT() asm volatile("s_waitcnt lgkmcnt(0)" ::: "memory")
#define VM_WAIT() asm volatile("s_waitcnt vmcnt(0)" ::: "memory")

constexpr int BATCH = 2, SEQ = 8192, DM = 4096, M = BATCH * SEQ;
constexpr int NQKV = 6144, FW = 2048, DFF = 11008, DFF2 = 22016;
constexpr float ALPHA = 1.189207115002721f, LN_EPS = 1e-5f;
constexpr float LAMBDA_INIT = 0.2f;

constexpr size_t MiB = 1u << 20;
constexpr size_t WS_CTL = 0, CTL_ZERO_BYTES = 64 * 1024;
constexpr size_t TAB_DFT256 = 1 * MiB;
constexpr size_t TAB_DFTC = 1 * MiB + 256 * 1024;
constexpr size_t TAB_TW = 1 * MiB + 512 * 1024;
constexpr size_t TAB_ROPEC = 2 * MiB;
constexpr size_t TAB_ROPES = 2 * MiB + 512 * 1024;
constexpr size_t WS_STAT0 = 3 * MiB;
constexpr size_t WS_STAT1 = 3 * MiB + 128 * 1024;
constexpr size_t W_DT = 4 * MiB;
constexpr size_t W_MT = W_DT + 86 * MiB;
constexpr size_t W_AOT = W_MT + 32 * MiB;
constexpr size_t W_FT = W_AOT + 16 * MiB;
constexpr size_t W_GT = W_FT + 16 * MiB;
constexpr size_t W_INT = W_GT + 64 * MiB;
constexpr size_t W_UPT = W_INT + 64 * MiB;
constexpr size_t WS_ACT = W_UPT + 172 * MiB + 128 * MiB;
constexpr size_t WS_HALO = WS_ACT + 344 * MiB;
constexpr size_t WS_AR = W_UPT + 172 * MiB;
constexpr size_t A_HB = WS_AR;
constexpr size_t A_UQKV = WS_AR + 128 * MiB;
constexpr size_t A_UFT = WS_AR + 320 * MiB;
constexpr size_t A_T = WS_AR + 384 * MiB;
constexpr size_t A_OP = WS_AR + 512 * MiB;
constexpr size_t A_ZT = WS_AR + 768 * MiB;
constexpr size_t A_ATTN = WS_AR + 320 * MiB;
constexpr size_t A_YF = WS_AR + 192 * MiB;
constexpr size_t A_YA = WS_AR + 512 * MiB;
constexpr size_t A_YFO = WS_AR + 640 * MiB;
constexpr size_t A_R1H = WS_AR + 512 * MiB;
constexpr size_t A_R2H = WS_AR + 640 * MiB;
constexpr size_t A_MIX = WS_AR + 384 * MiB;
constexpr size_t A_A = WS_AR + 128 * MiB;
constexpr size_t WS_END = WS_AR + 896 * MiB;
static_assert(WS_HALO + (size_t)64 * 4 * DFF2 * 4 <= WS_END, "act + halo fit in the arena");
static_assert(A_A + (size_t)M * DFF2 * 2 <= WS_END, "a fits");
constexpr int CW_BAR = 1024;

__device__ __forceinline__ unsigned f2bf(float f) { unsigned u = __builtin_bit_cast(unsigned, f); return (u + 0x7fffu + ((u >> 16) & 1u)) >> 16; }
__device__ __forceinline__ unsigned pk2(float lo, float hi) { unsigned r; asm("v_cvt_pk_bf16_f32 %0, %1, %2" : "=v"(r) : "v"(lo), "v"(hi)); return r; }
__device__ __forceinline__ float bf2f(unsigned short b) { return __builtin_bit_cast(float, ((unsigned)b) << 16); }
__device__ __forceinline__ float bflo(unsigned w) { return __builtin_bit_cast(float, w << 16); }
__device__ __forceinline__ float bfhi(unsigned w) { return __builtin_bit_cast(float, w & 0xffff0000u); }
__device__ __forceinline__ unsigned cvt_pk_bf16(float lo, float hi) { unsigned r; asm volatile("v_cvt_pk_bf16_f32 %0, %1, %2" : "=v"(r) : "v"(lo), "v"(hi)); return r; }
__device__ __forceinline__ float wave_sum(float v) {
#pragma unroll
    for (int o = 1; o < 64; o <<= 1) v += __shfl_xor(v, o);
    return v;
}
__device__ __forceinline__ int lane_id_fresh() { int l; asm volatile("v_mbcnt_lo_u32_b32 %0, -1, 0\n\tv_mbcnt_hi_u32_b32 %0, -1, %0" : "=v"(l)); return l; }
__device__ __forceinline__ float fast_sigmoid(float x) { return __builtin_amdgcn_rcpf(1.0f + __builtin_amdgcn_exp2f(-1.4426950408889634f * x)); }
__device__ __forceinline__ void sincos2pi(double x, float& s, float& c) {
    x -= floor(x);
    const int q = (int)(x * 4.0 + 0.5);
    const double r = (x - (double)q * 0.25) * 6.283185307179586476925;
    const double r2 = r * r;
    const double sn = r * (1.0 + r2 * (-1.0 / 6 + r2 * (1.0 / 120 + r2 * (-1.0 / 5040 + r2 * (1.0 / 362880 + r2 * (-1.0 / 39916800 + r2 * (1.0 / 6227020800.0)))))));
    const double cs = 1.0 + r2 * (-0.5 + r2 * (1.0 / 24 + r2 * (-1.0 / 720 + r2 * (1.0 / 40320 + r2 * (-1.0 / 3628800 + r2 * (1.0 / 479001600 + r2 * (-1.0 / 87178291200.0)))))));
    const int qq = q & 3;
    const double S = qq == 0 ? sn : qq == 1 ? cs : qq == 2 ? -sn : -cs;
    const double C = qq == 0 ? cs : qq == 1 ? -sn : qq == 2 ? -cs : sn;
    s = (float)S; c = (float)C;
}

#define XB_TMO      128
#define XB_XCNT(j)  (256  + 64 * (j))
#define XB_XSUB(j)  (1280 + 64 * (j))
#define XB_XGEN(j)  (2304 + 64 * (j))
#define XB_TOP      3328
#define XB_TOPGEN   3392
#define XCD_BAR_WORDS 3456
#define XB_SPIN_CAP (1u << 18)
__device__ __forceinline__ unsigned xb_ld(unsigned* p)              { return __hip_atomic_load(p, __ATOMIC_RELAXED, __HIP_MEMORY_SCOPE_AGENT); }
__device__ __forceinline__ unsigned xb_add(unsigned* p, unsigned v) { return __hip_atomic_fetch_add(p, v, __ATOMIC_RELAXED, __HIP_MEMORY_SCOPE_AGENT); }
__device__ __forceinline__ unsigned xb_xcc_id() { return (unsigned)__builtin_amdgcn_s_getreg((3 << 11) | 20) & 0xFu; }
#define XB_SPIN(cond, bar) do { unsigned _sp = 0; while (cond) { __builtin_amdgcn_s_sleep(1); \
    if ((++_sp & 255u) == 0u) { if (xb_ld(&(bar)[XB_TMO])) break; if (_sp > XB_SPIN_CAP) { atomicAdd(&(bar)[XB_TMO], 1u); break; } } } } while (0)
struct XcdBarrier { unsigned* bar; unsigned x; volatile LAS unsigned* st; };
__device__ __forceinline__ XcdBarrier xcd_barrier_post(unsigned* bar, volatile LAS unsigned* st, int wave) {
    XcdBarrier b; b.bar = bar; b.x = xb_xcc_id(); b.st = st;
    if (wave == 0 && lane_id_fresh() == 0) (void)xb_add(&bar[XB_XCNT(b.x)], 1u);
    return b;
}
__device__ __forceinline__ void xcd_barrier_complete(unsigned* bar, unsigned x, unsigned& nloc, unsigned& nx) {
    const unsigned G = gridDim.x * gridDim.y * gridDim.z;
    unsigned sum, cnt, mine, sp = 0u;
    for (;;) {
        sum = 0u; cnt = 0u; mine = 0u;
#pragma unroll
        for (unsigned j = 0; j < 16; ++j) { const unsigned c = xb_ld(&bar[XB_XCNT(j)]); sum += c; cnt += (c > 0u) ? 1u : 0u; mine = (j == x) ? c : mine; }
        if (sum == G) break;
        __builtin_amdgcn_s_sleep(1);
        if ((++sp & 255u) == 0u) { if (xb_ld(&bar[XB_TMO])) break; if (sp > XB_SPIN_CAP) { atomicAdd(&bar[XB_TMO], 1u); break; } }
    }
    nloc = mine > 0u ? mine : 1u; nx = cnt > 0u ? cnt : 1u;
}
__device__ __forceinline__ void xcd_barrier(const XcdBarrier& b, int wave) {
    asm volatile("s_waitcnt vmcnt(0)" ::: "memory");
    __syncthreads();
    if (wave == 0 && lane_id_fresh() == 0) {
        unsigned* bar = b.bar;
        __builtin_amdgcn_s_waitcnt(0);
        unsigned nloc = b.st[0], nx = b.st[1];
        if (nloc == 0u) { xcd_barrier_complete(bar, b.x, nloc, nx); b.st[0] = nloc; b.st[1] = nx; }
        const unsigned old = xb_add(&bar[XB_XSUB(b.x)], 1u);
        const unsigned gen = old / nloc;
        if (old + 1u == (gen + 1u) * nloc) {
            __builtin_amdgcn_fence(__ATOMIC_RELEASE, "agent");
            asm volatile("s_waitcnt vmcnt(0)" ::: "memory");
            const unsigned og = xb_add(&bar[XB_TOP], 1u);
            const unsigned tg = og / nx;
            if (og + 1u == (tg + 1u) * nx) xb_add(&bar[XB_TOPGEN], 1u);
            else XB_SPIN(xb_ld(&bar[XB_TOPGEN]) == tg, bar);
            __builtin_amdgcn_fence(__ATOMIC_ACQUIRE, "agent");
            xb_add(&bar[XB_XGEN(b.x)], 1u);
            asm volatile("s_waitcnt vmcnt(0)" ::: "memory");
        } else {
            XB_SPIN(xb_ld(&bar[XB_XGEN(b.x)]) == gen, bar);
            __builtin_amdgcn_fence(__ATOMIC_ACQUIRE, "agent");
            asm volatile("s_waitcnt vmcnt(0)" ::: "memory");
        }
    }
    __syncthreads();
}

namespace pg8 {
constexpr int BM = 256, BK = 64, HALF = 128, HTB = HALF * BK * 2, STAGE_BYTES = 8 * HTB, NXCD = 8, WGM = 8;
__host__ __device__ __forceinline__ int lds_byte(int r, int c) { const int st = (r >> 4) * 2 + (c >> 5), rr = r & 15, cc = c & 31, ob = rr * 64 + cc * 2; return st * 1024 + (ob ^ (((ob >> 9) & 1) << 5)); }
__host__ __device__ __forceinline__ void stage_rc(int b, int& R, int& C) { const int st = b / 1024, sb = b % 1024, swz = sb ^ (((sb >> 9) & 1) << 5); R = (st >> 1) * 16 + swz / 64; C = (st & 1) * 32 + (swz % 64) / 2; }
__host__ __device__ __forceinline__ int perm32(int rho) { const int n = rho >> 4, i = rho & 15; return 8 * (i >> 2) + 4 * n + (i & 3); }
struct Unit { int pm, pn; };
struct Gemm { const bf16* A; const bf16* Bt; unsigned lda, ldb; int K; };
struct StaticOrder {
    int nM, nN, nwg, G, c;
    __device__ void init(int M_, int N_, int G_, int c_) { nM = M_ / BM; nN = N_ / BM; nwg = nM * nN; G = G_; c = c_; }
    __device__ bool next(int i, Unit& u) const {
        const long L = (long)i * G + c; if (L >= nwg) return false;
        int wgid = (int)L; { const int q = nwg / NXCD, r = nwg % NXCD, xcd = wgid % NXCD, off = wgid / NXCD; wgid = (xcd < r ? xcd * (q + 1) : r * (q + 1) + (xcd - r) * q) + off; }
        const int nig = WGM * nN, gid = wgid / nig, fm = gid * WGM, gsz = (nM - fm) < WGM ? (nM - fm) : WGM;
        u.pm = fm + ((wgid % nig) % gsz); u.pn = (wgid % nig) / gsz; return true;
    }
};
struct AddrPlain { static __device__ __forceinline__ size_t offA(const Unit& u, const Gemm& g) { return (size_t)u.pm * 256 * g.lda * 2; }
                   static __device__ __forceinline__ size_t offB(const Unit& u, const Gemm& g) { return (size_t)u.pn * 256 * g.ldb * 2; } };
struct AddrF1 { static __device__ __forceinline__ size_t offA(const Unit& u, const Gemm& g) { return (size_t)u.pm * 256 * g.lda * 2; }
                static __device__ __forceinline__ size_t offB(const Unit& u, const Gemm&) { return ((size_t)(u.pn >> 5) * 8192 + (u.pn & 31)) * 4096 * 2; } };
struct AddrF2 { static __device__ __forceinline__ size_t offA(const Unit& u, const Gemm& g) { return (size_t)u.pm * 256 * g.lda * 2; }
                static __device__ __forceinline__ size_t offB(const Unit& u, const Gemm&) { return ((size_t)(u.pn >> 6) * 256 * 16384 + (size_t)(u.pn & 63) * 256) * 2; } };
struct AddrF4 { static __device__ __forceinline__ size_t offA(const Unit& u, const Gemm& g) { return ((size_t)u.pm * 256 * g.lda + (size_t)u.pn * 512) * 2; }
                static __device__ __forceinline__ size_t offB(const Unit&, const Gemm&) { return 0; } };

struct EpiBf16 {
    static constexpr bool PERM = true, APERM = false;
    bf16* O; unsigned ldc;
    __device__ __forceinline__ void operator()(const f32x4 (&acc)[2][2][4][2], const Unit& u, int wr, int wc, int fr, int fq) const {
        const char* base = (const char*)O + ((size_t)u.pm * BM * ldc + (size_t)u.pn * BM) * 2;
        const unsigned loff = ((unsigned)(wr * 64 + fr) * ldc + (unsigned)(wc * 32 + 8 * fq)) * 2u;
#pragma unroll
        for (int ai = 0; ai < 2; ++ai)
#pragma unroll
            for (int m = 0; m < 4; ++m) { const char* rb = base + (size_t)(ai * HALF + m * 16) * ldc * 2;
#pragma unroll
                for (int bj = 0; bj < 2; ++bj) { const f32x4 v0 = acc[ai][bj][m][0], v1 = acc[ai][bj][m][1];
                    v4u w; w.x = cvt_pk_bf16(v0[0], v0[1]); w.y = cvt_pk_bf16(v0[2], v0[3]); w.z = cvt_pk_bf16(v1[0], v1[1]); w.w = cvt_pk_bf16(v1[2], v1[3]);
                    *(v4u*)(rb + bj * HALF * 2 + loff) = w; } }
    }
};
struct EpiBf16Q {
    static constexpr bool PERM = true, APERM = false;
    bf16* O; unsigned ldc; float qscale; int qtiles; int rtiles; const float* ropec; const float* ropes;
    __device__ __forceinline__ void operator()(const f32x4 (&acc)[2][2][4][2], const Unit& u, int wr, int wc, int fr, int fq) const {
        const char* base = (const char*)O + ((size_t)u.pm * BM * ldc + (size_t)u.pn * BM) * 2;
        const unsigned loff = ((unsigned)(wr * 64 + fr) * ldc + (unsigned)(wc * 32 + 8 * fq)) * 2u;
        const float sc = (u.pn < qtiles) ? qscale : 1.0f;
        const bool rot = (u.pn < rtiles) && (wc == 0);
        const float sgn = fq < 2 ? -1.0f : 1.0f; const int fi = 8 * (fq & 1);
#pragma unroll
        for (int ai = 0; ai < 2; ++ai)
#pragma unroll
            for (int m = 0; m < 4; ++m) { const char* rb = base + (size_t)(ai * HALF + m * 16) * ldc * 2;
                f32x4 c0 = {1.f, 1.f, 1.f, 1.f}, c1 = c0, s0 = {0.f, 0.f, 0.f, 0.f}, s1 = s0;
                if (rot) { const int pos = (u.pm * BM + ai * HALF + wr * 64 + m * 16 + fr) & (SEQ - 1);
                    c0 = *(const f32x4*)(ropec + pos * 16 + fi); c1 = *(const f32x4*)(ropec + pos * 16 + fi + 4); s0 = *(const f32x4*)(ropes + pos * 16 + fi) * sgn; s1 = *(const f32x4*)(ropes + pos * 16 + fi + 4) * sgn; }
#pragma unroll
                for (int bj = 0; bj < 2; ++bj) { f32x4 v0 = acc[ai][bj][m][0], v1 = acc[ai][bj][m][1];
                    if (rot) { f32x4 p0, p1;
#pragma unroll
                        for (int e = 0; e < 4; ++e) { p0[e] = __shfl_xor(v0[e], 32); p1[e] = __shfl_xor(v1[e], 32); }
                        v0 = v0 * c0 + p0 * s0; v1 = v1 * c1 + p1 * s1; }
                    v0 *= sc; v1 *= sc;
                    v4u w; w.x = cvt_pk_bf16(v0[0], v0[1]); w.y = cvt_pk_bf16(v0[2], v0[3]); w.z = cvt_pk_bf16(v1[0], v1[1]); w.w = cvt_pk_bf16(v1[2], v1[3]);
                    *(v4u*)(rb + bj * HALF * 2 + loff) = w; } }
    }
};
struct EpiRes {
    static constexpr bool PERM = false, APERM = false;
    float* out; unsigned ldc; float alpha;
    __device__ __forceinline__ void operator()(const f32x4 (&acc)[2][2][4][2], const Unit& u, int wr, int wc, int fr, int fq) const {
        char* base = (char*)out + ((size_t)u.pm * BM * ldc + (size_t)u.pn * BM) * 4;
        const unsigned loff = ((unsigned)(wr * 64 + fr) * ldc + (unsigned)(wc * 32 + 4 * fq)) * 4u;
#pragma unroll
        for (int ai = 0; ai < 2; ++ai)
#pragma unroll
            for (int m = 0; m < 4; ++m) { char* rb = base + (size_t)(ai * HALF + m * 16) * ldc * 4;
#pragma unroll
                for (int bj = 0; bj < 2; ++bj)
#pragma unroll
                    for (int n = 0; n < 2; ++n) { f32x4* p = (f32x4*)(rb + (bj * HALF + n * 16) * 4 + loff); const f32x4 b = *p; *p = b * alpha + acc[ai][bj][m][n]; } }
    }
};
template <bool SRC16> struct EpiResLN {
    static constexpr bool PERM = false, APERM = false;
    _Float16* out; const void* src; const f32x2* stat; const float* gam; const float* bet; unsigned ldc; float alpha;
    __device__ __forceinline__ void operator()(const f32x4 (&acc)[2][2][4][2], const Unit& u, int wr, int wc, int fr, int fq) const {
        constexpr int SB = SRC16 ? 2 : 4;
        const size_t te = (size_t)u.pm * BM * ldc + (size_t)u.pn * BM;
        char* ob = (char*)out + te * 2; const char* sb = (const char*)src + te * SB;
        unsigned leo = (unsigned)(wr * 64 + fr) * ldc + (unsigned)(wc * 32 + 4 * fq);
        asm volatile("" : "+v"(leo));
        const unsigned coff = (unsigned)(u.pn * BM + wc * 32 + 4 * fq) * 4u;
        f32x4 g4[2][2], b4[2][2];
#pragma unroll
        for (int bj = 0; bj < 2; ++bj)
#pragma unroll
            for (int n = 0; n < 2; ++n) { g4[bj][n] = *(const f32x4*)((const char*)gam + coff + (bj * HALF + n * 16) * 4) * alpha; b4[bj][n] = *(const f32x4*)((const char*)bet + coff + (bj * HALF + n * 16) * 4) * alpha; }
        const f32x2* sp = stat + (size_t)u.pm * BM + wr * 64 + fr;
#pragma unroll
        for (int ai = 0; ai < 2; ++ai)
#pragma unroll
            for (int m = 0; m < 4; ++m) { const unsigned re = (unsigned)(ai * HALF + m * 16) * ldc + leo; const f32x2 st = sp[ai * HALF + m * 16];
#pragma unroll
                for (int bj = 0; bj < 2; ++bj)
#pragma unroll
                    for (int n = 0; n < 2; ++n) { const unsigned ce = bj * HALF + n * 16;
                        f32x4 v; if constexpr (SRC16) v = __builtin_convertvector(*(const h16x4*)(sb + (size_t)((re + ce) * 2u)), f32x4); else v = *(const f32x4*)(sb + (size_t)((re + ce) * 4u));
                        *(h16x4*)(ob + (size_t)((re + ce) * 2u)) = __builtin_convertvector((v - st.x) * st.y * g4[bj][n] + b4[bj][n] + acc[ai][bj][m][n], h16x4); }
                asm volatile("" ::: "memory"); }
    }
};
template <int CTRL> __device__ __forceinline__ float dpp_mov(float old, float src) {
    return __builtin_bit_cast(float, __builtin_amdgcn_update_dpp(__builtin_bit_cast(int, old), __builtin_bit_cast(int, src), CTRL, 0xf, 0xf, false)); }
struct EpiConv {
    static constexpr bool PERM = true, APERM = true;
    bf16* act; float* halo; const float* cw; const float* cb; unsigned ldsx;
    __device__ __forceinline__ void operator()(const f32x4 (&acc)[2][2][4][2], const Unit& u, int wr, int wc, int fr, int fq) const {
        LAS float* XL = (LAS float*)(uintptr_t)ldsx;
        const int cbase = wc * 32 + 8 * fq;
        if (fr == 0 || fr == 15) { const int which = fr == 0 ? 0 : 1;
#pragma unroll
            for (int ai = 0; ai < 2; ++ai)
#pragma unroll
                for (int bj = 0; bj < 2; ++bj)
#pragma unroll
                    for (int n = 0; n < 2; ++n) *(LAS f32x4*)(XL + ((((2 * ai + wr) * 2 + which) * 2 + bj) * 128 + cbase + 4 * n)) = fr == 0 ? acc[ai][bj][0][n] : acc[ai][bj][3][n]; }
        if ((wr == 0 && fr == 0) || (wr == 1 && fr == 15)) { float* hp = halo + ((size_t)u.pm * 4 + (wr == 0 ? 0 : 2)) * 22016 + u.pn * 128 + cbase;
#pragma unroll
            for (int bj = 0; bj < 2; ++bj)
#pragma unroll
                for (int n = 0; n < 2; ++n) { *(f32x4*)(hp + bj * 11008 + 4 * n) = wr == 0 ? acc[0][bj][0][n] : acc[1][bj][2][n]; *(f32x4*)(hp + 22016 + bj * 11008 + 4 * n) = wr == 0 ? acc[0][bj][1][n] : acc[1][bj][3][n]; } }
        asm volatile("s_waitcnt lgkmcnt(0)" ::: "memory"); __builtin_amdgcn_s_barrier(); asm volatile("" ::: "memory");
        const unsigned jc = (unsigned)(u.pn * 128 + cbase);
        char* ab = (char*)act + ((size_t)u.pm * BM * 11008 + jc) * 2; const unsigned aoffl = (unsigned)(wr * 64 + 4 * fr) * 11008u * 2u;
        unsigned lo[2][4][2];
#pragma unroll
        for (int n = 0; n < 2; ++n) {
            const f32x4 wg0 = *(const f32x4*)(cw + jc + 4 * n), wg1 = *(const f32x4*)(cw + 22016 + jc + 4 * n), wg2 = *(const f32x4*)(cw + 2 * 22016 + jc + 4 * n), bg = *(const f32x4*)(cb + jc + 4 * n);
            const f32x4 wv0 = *(const f32x4*)(cw + 11008 + jc + 4 * n), wv1 = *(const f32x4*)(cw + 22016 + 11008 + jc + 4 * n), wv2 = *(const f32x4*)(cw + 2 * 22016 + 11008 + jc + 4 * n), bv = *(const f32x4*)(cb + 11008 + jc + 4 * n);
#pragma unroll
            for (int ai = 0; ai < 2; ++ai) { const int b = 2 * ai + wr;
                const f32x4 z4 = {0.f, 0.f, 0.f, 0.f};
                const f32x4 pG = b > 0 ? *(const LAS f32x4*)(XL + ((((b - 1) * 2 + 1) * 2 + 0) * 128 + cbase + 4 * n)) : z4, pV = b > 0 ? *(const LAS f32x4*)(XL + ((((b - 1) * 2 + 1) * 2 + 1) * 128 + cbase + 4 * n)) : z4;
                const f32x4 nG = b < 3 ? *(const LAS f32x4*)(XL + ((((b + 1) * 2 + 0) * 2 + 0) * 128 + cbase + 4 * n)) : z4, nV = b < 3 ? *(const LAS f32x4*)(XL + ((((b + 1) * 2 + 0) * 2 + 1) * 128 + cbase + 4 * n)) : z4;
                f32x4 gprev, vprev, gnext, vnext;
#pragma unroll
                for (int e = 0; e < 4; ++e) {
                    gprev[e] = dpp_mov<0x111>(pG[e], acc[ai][0][3][n][e]); vprev[e] = dpp_mov<0x111>(pV[e], acc[ai][1][3][n][e]);
                    gnext[e] = dpp_mov<0x101>(nG[e], acc[ai][0][0][n][e]); vnext[e] = dpp_mov<0x101>(nV[e], acc[ai][1][0][n][e]); }
#pragma unroll
                for (int m = 0; m < 4; ++m) {
                    const f32x4 gp = m > 0 ? acc[ai][0][m - 1][n] : gprev, vp = m > 0 ? acc[ai][1][m - 1][n] : vprev;
                    const f32x4 gn = m < 3 ? acc[ai][0][m + 1][n] : gnext, vn = m < 3 ? acc[ai][1][m + 1][n] : vnext;
                    const f32x4 cg = wg0 * gp + wg1 * acc[ai][0][m][n] + wg2 * gn + bg, cv = wv0 * vp + wv1 * acc[ai][1][m][n] + wv2 * vn + bv;
                    const unsigned p0 = cvt_pk_bf16(cg[0] * fast_sigmoid(cg[0]) * cv[0], cg[1] * fast_sigmoid(cg[1]) * cv[1]), p1 = cvt_pk_bf16(cg[2] * fast_sigmoid(cg[2]) * cv[2], cg[3] * fast_sigmoid(cg[3]) * cv[3]);
                    if (n == 0) { lo[ai][m][0] = p0; lo[ai][m][1] = p1; }
                    else { v4u w; w.x = lo[ai][m][0]; w.y = lo[ai][m][1]; w.z = p0; w.w = p1; *(v4u*)(ab + (size_t)(ai * HALF + m) * 11008 * 2 + aoffl) = w; } } } }
    }
};
struct EpiGateMix {
    static constexpr bool PERM = true, APERM = false;
    const bf16* ya; const bf16* yf; const float* bgate; bf16* mixed;
    __device__ __forceinline__ void operator()(const f32x4 (&acc)[2][2][4][2], const Unit& u, int wr, int wc, int fr, int fq) const {
        const size_t tb = ((size_t)u.pm * BM * 4096 + (size_t)u.pn * HALF) * 2;
        const char* yab = (const char*)ya + tb; const char* yfb = (const char*)yf + tb; char* mxb = (char*)mixed + tb;
        const unsigned loff = ((unsigned)(wr * 64 + fr) * 4096u + (unsigned)(wc * 32 + 8 * fq)) * 2u;
        const float* bgp = bgate + u.pn * HALF; const unsigned boff = (unsigned)(wc * 32 + 8 * fq) * 4u;
        const f32x4 ba0 = *(const f32x4*)((const char*)bgp + boff), ba1 = *(const f32x4*)((const char*)bgp + boff + 16), bf0 = *(const f32x4*)((const char*)bgp + 16384 + boff), bf1 = *(const f32x4*)((const char*)bgp + 16384 + boff + 16);
#pragma unroll
        for (int ai = 0; ai < 2; ++ai)
#pragma unroll
            for (int m = 0; m < 4; ++m) { const size_t ro = (size_t)(ai * HALF + m * 16) * 4096 * 2;
                const v4u a = *(const v4u*)(yab + ro + loff), f = *(const v4u*)(yfb + ro + loff);
                const f32x4 ga0 = acc[ai][0][m][0] + ba0, ga1 = acc[ai][0][m][1] + ba1, gf0 = acc[ai][1][m][0] + bf0, gf1 = acc[ai][1][m][1] + bf1;
                float r[8];
                r[0] = fast_sigmoid(ga0[0]) * bflo(a.x) + fast_sigmoid(gf0[0]) * bflo(f.x); r[1] = fast_sigmoid(ga0[1]) * bfhi(a.x) + fast_sigmoid(gf0[1]) * bfhi(f.x);
                r[2] = fast_sigmoid(ga0[2]) * bflo(a.y) + fast_sigmoid(gf0[2]) * bflo(f.y); r[3] = fast_sigmoid(ga0[3]) * bfhi(a.y) + fast_sigmoid(gf0[3]) * bfhi(f.y);
                r[4] = fast_sigmoid(ga1[0]) * bflo(a.z) + fast_sigmoid(gf1[0]) * bflo(f.z); r[5] = fast_sigmoid(ga1[1]) * bfhi(a.z) + fast_sigmoid(gf1[1]) * bfhi(f.z);
                r[6] = fast_sigmoid(ga1[2]) * bflo(a.w) + fast_sigmoid(gf1[2]) * bflo(f.w); r[7] = fast_sigmoid(ga1[3]) * bfhi(a.w) + fast_sigmoid(gf1[3]) * bfhi(f.w);
                v4u w; w.x = cvt_pk_bf16(r[0], r[1]); w.y = cvt_pk_bf16(r[2], r[3]); w.z = cvt_pk_bf16(r[4], r[5]); w.w = cvt_pk_bf16(r[6], r[7]);
                *(v4u*)(mxb + ro + loff) = w; }
    }
};

template <class Epi, class Addr, bool ALIGN_EPI = true>
__device__ __forceinline__ void gemm_phase(LAS unsigned char* lds, const Gemm g, const StaticOrder& S, const Epi& E, const int wid) {
    const int lane = lane_id_fresh(), tid = wid * 64 + lane,
              wr = wid >> 2, wc = wid & 3, fr = lane & 15, fq = lane >> 4;
    const int K = g.K, nt = K / BK;
    unsigned voffA[2], voffB[2];
#pragma unroll
    for (int i = 0; i < 2; ++i) { int R, C; stage_rc(tid * 16 + i * 8192, R, C); const int Rb = Epi::PERM ? ((R & ~31) + perm32(R & 31)) : R;
        const int Ra = Epi::APERM ? ((R & 64) + 4 * (R & 15) + ((R >> 4) & 3)) : R;
        voffA[i] = ((unsigned)Ra * g.lda + (unsigned)C) * 2u; voffB[i] = ((unsigned)Rb * g.ldb + (unsigned)C) * 2u; }
    const size_t kstep = (size_t)(BK * 2);
    const size_t hstepA = (size_t)HALF * g.lda * 2, hstepB = (size_t)HALF * g.ldb * 2;
    const unsigned ldsw = (unsigned)wid * 1024u, ldsbase = (unsigned)(uintptr_t)lds;
    const int aoff = lds_byte(wr * 64 + fr, fq * 8), boff = lds_byte(wc * 32 + fr, fq * 8);
#define PG8_SA(b, h) (((b) * 2 + (h)) * HTB)
#define PG8_SB(b, h) ((4 + (b) * 2 + (h)) * HTB)
#define PG8_STAGE(bufoff, gbase, voff) do { const unsigned la0_ = ldsbase + (unsigned)(bufoff) + ldsw, la1_ = la0_ + 8192u; const char* gb_ = (const char*)(gbase); unsigned keep_; \
        asm volatile("s_mov_b32 %0, m0\n\ts_mov_b32 m0, %4\n\ts_nop 0\n\tglobal_load_lds_dwordx4 %1, %3\n\ts_mov_b32 m0, %5\n\ts_nop 0\n\tglobal_load_lds_dwordx4 %2, %3\n\ts_mov_b32 m0, %0" \
                     : "=&s"(keep_) : "v"((voff)[0]), "v"((voff)[1]), "s"(gb_), "s"(la0_), "s"(la1_) : "memory"); } while (0)
#define PG8_LDA(dst, b, h) do { _Pragma("unroll") for (int m = 0; m < 4; ++m) _Pragma("unroll") for (int k = 0; k < 2; ++k) dst[m][k] = *(const LAS bf16x8*)(lds + PG8_SA(b, h) + aoff + m * 2048 + k * 1024); } while (0)
#define PG8_LDB(dst, b, h) do { _Pragma("unroll") for (int n = 0; n < 2; ++n) _Pragma("unroll") for (int k = 0; k < 2; ++k) dst[n][k] = *(const LAS bf16x8*)(lds + PG8_SB(b, h) + boff + n * 2048 + k * 1024); } while (0)
#define PG8_MMA(ai, bj, At, Bt) do { __builtin_amdgcn_s_setprio(1); _Pragma("unroll") for (int m = 0; m < 4; ++m) _Pragma("unroll") for (int n = 0; n < 2; ++n) _Pragma("unroll") for (int k = 0; k < 2; ++k) \
        acc[ai][bj][m][n] = __builtin_amdgcn_mfma_f32_16x16x32_bf16(Bt[n][k], At[m][k], acc[ai][bj][m][n], 0, 0, 0); __builtin_amdgcn_s_setprio(0); } while (0)
#define PG8_WAIT_V(n) asm volatile("s_waitcnt vmcnt(" #n ")" ::: "memory")
#define PG8_WAIT_L(n) asm volatile("s_waitcnt lgkmcnt(" #n ")" ::: "memory")
#define PG8_BAR __builtin_amdgcn_s_barrier()
#define PG8_SCHED __builtin_amdgcn_sched_barrier(0)
    Unit cur, nxt; int ui = 0;
    if (!S.next(0, cur)) return;
    f32x4 acc[2][2][4][2];
#pragma unroll
    for (int a = 0; a < 2; ++a)
#pragma unroll
        for (int b = 0; b < 2; ++b)
#pragma unroll
            for (int m = 0; m < 4; ++m)
#pragma unroll
                for (int n = 0; n < 2; ++n) acc[a][b][m][n] = (f32x4){0.f, 0.f, 0.f, 0.f};
    bf16x8 At[4][2], B0[2][2], B1[2][2];
    const char* cA = (const char*)g.A + Addr::offA(cur, g); const char* cB = (const char*)g.Bt + Addr::offB(cur, g);
    PG8_STAGE(PG8_SB(0, 0), cB, voffB); PG8_STAGE(PG8_SB(0, 1), cB + hstepB, voffB); PG8_STAGE(PG8_SA(0, 0), cA, voffA); PG8_STAGE(PG8_SA(0, 1), cA + hstepA, voffA);
    if (wr == 1) PG8_BAR;
    PG8_WAIT_V(2); PG8_BAR;
    PG8_STAGE(PG8_SB(1, 0), cB + kstep, voffB); PG8_STAGE(PG8_SA(1, 0), cA + kstep, voffA); PG8_STAGE(PG8_SB(1, 1), cB + hstepB + kstep, voffB);
    PG8_WAIT_V(6); PG8_BAR;
    for (;;) {
        const bool has_next = S.next(ui + 1, nxt);
        const char* nA = has_next ? (const char*)g.A + Addr::offA(nxt, g) : cA; const char* nB = has_next ? (const char*)g.Bt + Addr::offB(nxt, g) : cB;
        for (int t = 0; t < nt; t += 2) {
            const bool last = (t == nt - 2);
            const char* a1 = cA + (size_t)(t + 1) * kstep;
            const char* a2 = last ? nA : cA + (size_t)(t + 2) * kstep; const char* b2 = last ? nB : cB + (size_t)(t + 2) * kstep;
            const char* a3 = a2 + kstep; const char* b3 = b2 + kstep;
            PG8_LDB(B0, 0, 0); PG8_LDB(B1, 0, 1); PG8_SCHED; PG8_LDA(At, 0, 0); PG8_STAGE(PG8_SA(1, 1), a1 + hstepA, voffA);
            PG8_WAIT_V(8); PG8_WAIT_L(0); PG8_BAR; PG8_MMA(0, 0, At, B0); PG8_MMA(0, 1, At, B1); PG8_BAR; PG8_SCHED;
            PG8_LDA(At, 0, 1); PG8_STAGE(PG8_SB(0, 0), b2, voffB); PG8_STAGE(PG8_SB(0, 1), b2 + hstepB, voffB); PG8_STAGE(PG8_SA(0, 0), a2, voffA);
            PG8_WAIT_V(8); PG8_WAIT_L(0); PG8_BAR; PG8_MMA(1, 0, At, B0); PG8_MMA(1, 1, At, B1); PG8_BAR; PG8_SCHED;
            PG8_LDB(B0, 1, 0); PG8_LDB(B1, 1, 1); PG8_SCHED; PG8_LDA(At, 1, 0); PG8_STAGE(PG8_SA(0, 1), a2 + hstepA, voffA);
            PG8_WAIT_V(8); PG8_WAIT_L(0); PG8_BAR; PG8_MMA(0, 0, At, B0); PG8_MMA(0, 1, At, B1); PG8_BAR; PG8_SCHED;
            PG8_LDA(At, 1, 1); PG8_STAGE(PG8_SB(1, 0), b3, voffB); PG8_STAGE(PG8_SB(1, 1), b3 + hstepB, voffB); PG8_STAGE(PG8_SA(1, 0), a3, voffA);
            PG8_WAIT_V(8); PG8_WAIT_L(0); PG8_BAR; PG8_MMA(1, 0, At, B0); PG8_MMA(1, 1, At, B1); PG8_BAR; PG8_SCHED;
        }
        if constexpr (ALIGN_EPI) { if (wr == 0) PG8_BAR; }
        E(acc, cur, wr, wc, fr, fq);
        if (!has_next) break;
#pragma unroll
        for (int a = 0; a < 2; ++a)
#pragma unroll
            for (int b = 0; b < 2; ++b)
#pragma unroll
                for (int m = 0; m < 4; ++m)
#pragma unroll
                    for (int n = 0; n < 2; ++n) acc[a][b][m][n] = (f32x4){0.f, 0.f, 0.f, 0.f};
        cur = nxt; cA = nA; cB = nB; ++ui;
        if constexpr (ALIGN_EPI) { if (wr == 1) PG8_BAR; }
    }
    PG8_WAIT_V(0);
    if constexpr (!ALIGN_EPI) { if (wr == 0) PG8_BAR; }
    PG8_BAR;
#undef PG8_SA
#undef PG8_SB
#undef PG8_STAGE
#undef PG8_LDA
#undef PG8_LDB
#undef PG8_MMA
#undef PG8_WAIT_V
#undef PG8_WAIT_L
#undef PG8_BAR
#undef PG8_SCHED
}
}

namespace att {
constexpr int D = 128, NW = 8, QBLK = 32, KVBLK = 64;
constexpr float SCALE = 0.088388347648318440f;
constexpr float THR = 8.f;
constexpr int LDQ = NQKV, LDK = NQKV, LDO = 4096;
constexpr size_t SHM_V = KVBLK * D * 2, SHM_K = KVBLK * D * 2, SHM_ATTN = 2 * SHM_V + 2 * SHM_K + NW * 64 * 4;
using s16x4 = __attribute__((ext_vector_type(4))) short;
using f32x16 = __attribute__((ext_vector_type(16))) float;
#define KSWZ(row, colB) ((row) * 256 + ((colB) ^ (((row) & 7) << 4)))
#define SBAR() __builtin_amdgcn_sched_barrier(0)
__device__ __forceinline__ int crow(int r, int hi) { return (r & 3) + 8 * (r >> 2) + 4 * hi; }
__device__ __forceinline__ unsigned cvtpk(float lo, float hi) { unsigned r; asm volatile("v_cvt_pk_bf16_f32 %0, %1, %2" : "=v"(r) : "v"(lo), "v"(hi)); return r; }
__device__ __forceinline__ void partialSM(f32x16& p0, f32x16& p1, float& m_reg, float& mn, float& alpha) {
  constexpr float C = SCALE * 1.4426950408889634f;
  float pmax = p0[0];
#pragma unroll
  for (int r = 1; r < 16; ++r) pmax = fmaxf(pmax, p0[r]);
#pragma unroll
  for (int r = 0; r < 16; ++r) pmax = fmaxf(pmax, p1[r]);
  { auto rr = __builtin_amdgcn_permlane32_swap(__float_as_uint(pmax), __float_as_uint(pmax), false, false);
    pmax = fmaxf(__uint_as_float(rr[0]), __uint_as_float(rr[1])); }
  if (__builtin_expect(__all(pmax - m_reg <= THR / SCALE), 1)) { mn = m_reg; alpha = 1.f; }
  else { mn = fmaxf(m_reg, pmax); alpha = __builtin_amdgcn_exp2f((m_reg - mn) * C); m_reg = mn; }
  float mnC = -mn * C;
#pragma unroll
  for (int r = 0; r < 16; ++r) p0[r] = fmaf(p0[r], C, mnC);
#pragma unroll
  for (int r = 0; r < 16; ++r) p1[r] = fmaf(p1[r], C, mnC);
#pragma unroll
  for (int r = 0; r < 16; ++r) p0[r] = __builtin_amdgcn_exp2f(p0[r]);
}
__device__ __forceinline__ void finishSM(f32x16& p0, f32x16& p1, float alpha, float& l_reg, bf16x8& pa0, bf16x8& pa1, bf16x8& pa2, bf16x8& pa3) {
#pragma unroll
  for (int r = 0; r < 16; ++r) p1[r] = __builtin_amdgcn_exp2f(p1[r]);
  float ps = 0;
#pragma unroll
  for (int r = 0; r < 16; ++r) ps += p0[r];
#pragma unroll
  for (int r = 0; r < 16; ++r) ps += p1[r];
  { auto rr = __builtin_amdgcn_permlane32_swap(__float_as_uint(ps), __float_as_uint(ps), false, false);
    ps = __uint_as_float(rr[0]) + __uint_as_float(rr[1]); }
  l_reg = l_reg * alpha + ps;
#define PK4(P, BASE, OUT) do { unsigned a0 = cvtpk(P[BASE + 0], P[BASE + 1]), a1 = cvtpk(P[BASE + 2], P[BASE + 3]);   \
    unsigned b0 = cvtpk(P[BASE + 4], P[BASE + 5]), b1 = cvtpk(P[BASE + 6], P[BASE + 7]);                              \
    auto r0 = __builtin_amdgcn_permlane32_swap(a0, b0, false, false); auto r1 = __builtin_amdgcn_permlane32_swap(a1, b1, false, false); \
    v4u w = {r0[0], r1[0], r0[1], r1[1]}; OUT = *reinterpret_cast<bf16x8*>(&w); } while (0)
  PK4(p0, 0, pa0); PK4(p0, 8, pa1); PK4(p1, 0, pa2); PK4(p1, 8, pa3);
#undef PK4
}
__device__ __forceinline__ void qkt(f32x16& p0, f32x16& p1, const bf16* Ks, const bf16x8* qr, int r32, int hi) {
  p0 = f32x16{}; p1 = f32x16{};
#pragma unroll
  for (int d0 = 0; d0 < 8; ++d0) { int cb = (d0 * 16 + hi * 8) * 2;
    bf16x8 b0 = *reinterpret_cast<const bf16x8*>((const char*)Ks + KSWZ(r32, cb));
    bf16x8 b1 = *reinterpret_cast<const bf16x8*>((const char*)Ks + KSWZ(32 + r32, cb));
    p0 = __builtin_amdgcn_mfma_f32_32x32x16_bf16(b0, qr[d0], p0, 0, 0, 0);
    p1 = __builtin_amdgcn_mfma_f32_32x32x16_bf16(b1, qr[d0], p1, 0, 0, 0); }
}
__device__ __forceinline__ int v_st(int k, int c) { const int kk = (k & ~0xC) | ((k & 4) << 1) | ((k & 8) >> 1); return ((kk >> 3) * 4 + (c >> 5)) * 512 + ((kk & 7) * 32 + (c & 31)) * 2; }
__device__ __forceinline__ int v_rd_base(int lane) { return ((lane & 3) << 3) | (((lane >> 2) & 3) << 6) | (((lane >> 4) & 1) << 5) | (((lane >> 5) & 1) << 8); }
constexpr int v_rd_off(int d0, int ks, int half) { return d0 * 512 + ks * 4096 + half * 2048; }
template <int OFF> __device__ __forceinline__ s16x4 tr_read(int vb) {
  s16x4 r; asm volatile("ds_read_b64_tr_b16 %0, %1 offset:%2" : "=&v"(r) : "v"(vb), "i"(OFF) : "memory"); return r;
}
template <int D0> __device__ __forceinline__ void pv_one(f32x16& od, int vb, bf16x8 pa0, bf16x8 pa1, bf16x8 pa2, bf16x8 pa3) {
  const s16x4 l0 = tr_read<v_rd_off(D0, 0, 0)>(vb), h0 = tr_read<v_rd_off(D0, 0, 1)>(vb), l1 = tr_read<v_rd_off(D0, 1, 0)>(vb), h1 = tr_read<v_rd_off(D0, 1, 1)>(vb);
  const s16x4 l2 = tr_read<v_rd_off(D0, 2, 0)>(vb), h2 = tr_read<v_rd_off(D0, 2, 1)>(vb), l3 = tr_read<v_rd_off(D0, 3, 0)>(vb), h3 = tr_read<v_rd_off(D0, 3, 1)>(vb);
  asm volatile("s_waitcnt lgkmcnt(0)" ::: "memory"); SBAR();
#define PK(L, H) (bf16x8){L[0], L[1], L[2], L[3], H[0], H[1], H[2], H[3]}
  od = __builtin_amdgcn_mfma_f32_32x32x16_bf16(pa0, PK(l0, h0), od, 0, 0, 0);
  od = __builtin_amdgcn_mfma_f32_32x32x16_bf16(pa1, PK(l1, h1), od, 0, 0, 0);
  od = __builtin_amdgcn_mfma_f32_32x32x16_bf16(pa2, PK(l2, h2), od, 0, 0, 0);
  od = __builtin_amdgcn_mfma_f32_32x32x16_bf16(pa3, PK(l3, h3), od, 0, 0, 0);
#undef PK
}
__device__ __forceinline__ void pv_d0(f32x16* o, int vb, bf16x8 pa0, bf16x8 pa1, bf16x8 pa2, bf16x8 pa3) {
  pv_one<0>(o[0], vb, pa0, pa1, pa2, pa3); pv_one<1>(o[1], vb, pa0, pa1, pa2, pa3); pv_one<2>(o[2], vb, pa0, pa1, pa2, pa3); pv_one<3>(o[3], vb, pa0, pa1, pa2, pa3);
}
__device__ __forceinline__ void attn_dense_body(const bf16* __restrict__ Qb, const bf16* __restrict__ Kh, const bf16* __restrict__ Vh, float* __restrict__ Ob, int seq, char* lds, const int wid) {
  const int lane = lane_id_fresh(), tid = wid * 64 + lane, r32 = lane & 31, hi = lane >> 5;
  bf16* V_lds = (bf16*)lds; bf16* K_lds = (bf16*)(lds + 2 * SHM_V);
  float* ws = (float*)(lds + 2 * SHM_V + 2 * SHM_K) + wid * 64; float* li_l = ws; float* al_l = ws + 32;
  float m_reg = -1e30f, l_reg = 0; f32x16 o[4] = {}; bf16x8 qr[8];
  const bf16* Qw = Qb + (long)(wid * QBLK + r32) * LDQ + hi * 8;
#pragma unroll
  for (int d0 = 0; d0 < 8; ++d0) qr[d0] = *reinterpret_cast<const bf16x8*>(Qw + d0 * 16);
  const int sr = tid >> 4, sc = (tid & 15) * 8, vst0 = v_st(sr, sc), vst1 = v_st(32 + sr, sc);
  const int vb0 = (int)(uintptr_t)V_lds + v_rd_base(lane);
  const unsigned goff0 = (unsigned)(sr * LDK + sc) * 2u, goff1 = goff0 + 32u * LDK * 2u;
  struct { bf16x8 vs0, vs1, ks0, ks1; } sr_[2];
#define SLOAD(i, k0) do { const char* kb_ = (const char*)Kh + (size_t)(k0) * (LDK * 2); const char* vb_ = (const char*)Vh + (size_t)(k0) * (LDK * 2); \
    sr_[i].vs0 = *reinterpret_cast<const bf16x8*>(vb_ + goff0); sr_[i].vs1 = *reinterpret_cast<const bf16x8*>(vb_ + goff1); \
    sr_[i].ks0 = *reinterpret_cast<const bf16x8*>(kb_ + goff0); sr_[i].ks1 = *reinterpret_cast<const bf16x8*>(kb_ + goff1); } while (0)
#define SWRITE(b, i) do { *(bf16x8*)((char*)V_lds + (b) * SHM_V + vst0) = sr_[i].vs0;          \
    *(bf16x8*)((char*)V_lds + (b) * SHM_V + vst1) = sr_[i].vs1; int kc = sc * 2;               \
    *(bf16x8*)((char*)K_lds + (b) * SHM_K + KSWZ(sr, kc)) = sr_[i].ks0;                       \
    *(bf16x8*)((char*)K_lds + (b) * SHM_K + KSWZ(32 + sr, kc)) = sr_[i].ks1; } while (0)
#define SWAIT() asm volatile("s_waitcnt vmcnt(4)" ::: "memory")
#define RESC(a) do { if (__any((a) < 1.f)) { if (hi == 0) al_l[r32] = (a); asm volatile("s_waitcnt lgkmcnt(0)" ::: "memory"); \
    _Pragma("unroll") for (int d = 0; d < 4; ++d) _Pragma("unroll") for (int r = 0; r < 16; ++r) o[d][r] *= al_l[crow(r, hi)]; } } while (0)
  f32x16 pA0, pA1, pB0, pB1; float mnA, mnB, alA, alB; bf16x8 pa0, pa1, pa2, pa3; const int NT = seq / KVBLK;
  constexpr int SE = 0, SO = 1;
  SLOAD(SE, 0); asm volatile("s_waitcnt vmcnt(0)" ::: "memory"); SWRITE(0, SE); __syncthreads();
  qkt(pA0, pA1, K_lds, qr, r32, hi); partialSM(pA0, pA1, m_reg, mnA, alA);
  SLOAD(SO, KVBLK); if (2 < NT) SLOAD(SE, 2 * KVBLK);
  SWAIT(); SWRITE(1, SO); __syncthreads();
  for (int j = 1; j + 1 < NT; j += 2) {
    SBAR(); qkt(pB0, pB1, (bf16*)((char*)K_lds + SHM_K), qr, r32, hi);
    finishSM(pA0, pA1, alA, l_reg, pa0, pa1, pa2, pa3); SBAR();
    SLOAD(SO, (j + 2) * KVBLK); SBAR();
    pv_d0(o, vb0, pa0, pa1, pa2, pa3); partialSM(pB0, pB1, m_reg, mnB, alB);
    __syncthreads(); SWAIT(); SWRITE(0, SE);
    RESC(alB); __syncthreads();
    SBAR(); qkt(pA0, pA1, K_lds, qr, r32, hi);
    finishSM(pB0, pB1, alB, l_reg, pa0, pa1, pa2, pa3); SBAR();
    if (j + 3 < NT) SLOAD(SE, (j + 3) * KVBLK); SBAR();
    pv_d0(o, vb0 + (int)SHM_V, pa0, pa1, pa2, pa3); partialSM(pA0, pA1, m_reg, mnA, alA);
    __syncthreads(); SWAIT(); SWRITE(1, SO);
    RESC(alA); __syncthreads();
  }
  SBAR(); qkt(pB0, pB1, (bf16*)((char*)K_lds + SHM_K), qr, r32, hi);
  finishSM(pA0, pA1, alA, l_reg, pa0, pa1, pa2, pa3); SBAR();
  pv_d0(o, vb0, pa0, pa1, pa2, pa3); partialSM(pB0, pB1, m_reg, mnB, alB);
  __syncthreads(); RESC(alB);
  finishSM(pB0, pB1, alB, l_reg, pa0, pa1, pa2, pa3); SBAR();
  pv_d0(o, vb0 + (int)SHM_V, pa0, pa1, pa2, pa3);
  if (hi == 0) li_l[r32] = l_reg; asm volatile("s_waitcnt lgkmcnt(0)" ::: "memory");
  float rli[16];
#pragma unroll
  for (int r = 0; r < 16; ++r) rli[r] = __builtin_amdgcn_rcpf(li_l[crow(r, hi)]);
  float* Ow = Ob + (long)(wid * QBLK) * LDO;
#pragma unroll
  for (int r = 0; r < 16; ++r) { int orow = crow(r, hi);
#pragma unroll
    for (int d0 = 0; d0 < 4; ++d0) Ow[(long)orow * LDO + d0 * 32 + r32] = o[d0][r] * rli[r]; }
  __syncthreads();
#undef SLOAD
#undef SWRITE
#undef SWAIT
#undef RESC
}
}

namespace att2 {
using att::f32x16; using att::s16x4; using att::crow; using att::cvtpk; using att::tr_read; using att::v_rd_base;
constexpr int KVBLK = 64, LDK = NQKV, LDQ = NQKV, LDO = 4096;
constexpr float SCALE = att::SCALE, THR = att::THR;
constexpr int KB0 = 0, VB0 = 49152, SCR = 114688;
constexpr int CST = 139264;
constexpr int LDS_NEED = CST + 2048;
template <int OFF> __device__ __forceinline__ bf16x8 k_read(int va) { bf16x8 r; asm volatile("ds_read_b128 %0, %1 offset:%2" : "=&v"(r) : "v"(va), "i"(OFF) : "memory"); return r; }
template <int D0> __device__ __forceinline__ void pv_one(f32x16& od, int vb, bf16x8 pa0, bf16x8 pa1, bf16x8 pa2, bf16x8 pa3) {
  constexpr int B = (D0 & 3) * 512 + (D0 >> 2) * 16384;
  const s16x4 l0 = tr_read<B + 0>(vb), h0 = tr_read<B + 2048>(vb), l1 = tr_read<B + 4096>(vb), h1 = tr_read<B + 4096 + 2048>(vb);
  const s16x4 l2 = tr_read<B + 8192>(vb), h2 = tr_read<B + 8192 + 2048>(vb), l3 = tr_read<B + 12288>(vb), h3 = tr_read<B + 12288 + 2048>(vb);
  asm volatile("s_waitcnt lgkmcnt(0)" ::: "memory"); SBAR();
#define PK(L, H) (bf16x8){L[0], L[1], L[2], L[3], H[0], H[1], H[2], H[3]}
  od = __builtin_amdgcn_mfma_f32_32x32x16_bf16(pa0, PK(l0, h0), od, 0, 0, 0);
  od = __builtin_amdgcn_mfma_f32_32x32x16_bf16(pa1, PK(l1, h1), od, 0, 0, 0);
  od = __builtin_amdgcn_mfma_f32_32x32x16_bf16(pa2, PK(l2, h2), od, 0, 0, 0);
  od = __builtin_amdgcn_mfma_f32_32x32x16_bf16(pa3, PK(l3, h3), od, 0, 0, 0);
#undef PK
}
__device__ __forceinline__ void attn_body(const bf16* __restrict__ Qb, const bf16* __restrict__ Kh, const bf16* __restrict__ Vh, float* __restrict__ Ob, int seq, LAS unsigned char* lds, const int wid, const bool fin) {
  const int lane = lane_id_fresh(), r32 = lane & 31, hi = lane >> 5;
  LAS float* wsf = (LAS float*)(lds + SCR) + wid * 64; LAS float* li_l = wsf; LAS float* al_l = wsf + 32;
  float m_reg = 0.f, l_reg = 0; f32x16 o[8] = {}; bf16x8 qr[8];
  const bf16* Qw = Qb + (long)(wid * 32 + r32) * LDQ + hi * 8;
#pragma unroll
  for (int d0 = 0; d0 < 8; ++d0) qr[d0] = *reinterpret_cast<const bf16x8*>(Qw + d0 * 16);
  const int grp = wid >> 2, wb = wid & 3;
  unsigned kofs0, kofs1, vofs;
  { const int l4 = lane >> 4; kofs0 = (unsigned)((16 * wb + l4) * LDK * 2 + (((lane & 15) ^ l4) * 16)); kofs1 = (unsigned)((16 * wb + l4) * LDK * 2 + (((lane & 15) ^ (4 + l4)) * 16));
    const int r8 = (lane >> 2) & 7; vofs = (unsigned)((16 * wb + 8 * (r8 >> 2) + (r8 & 3)) * LDK * 2 + (lane >> 5) * 64 + (lane & 3) * 16); }
  const unsigned dsto = (unsigned)wb * 4096u;
  const unsigned ldsk0 = (unsigned)(uintptr_t)(lds + KB0) + dsto, ldsv0 = (unsigned)(uintptr_t)(lds + VB0) + dsto;
#define ISSUE_K(buf, k0) do { const char* kb0_ = (const char*)Kh + (size_t)(k0) * (LDK * 2); const char* kb1_ = kb0_ + 4 * LDK * 2; const char* kb2_ = kb0_ + 8 * LDK * 2; const char* kb3_ = kb0_ + 12 * LDK * 2; \
    const unsigned lk_ = ldsk0 + (unsigned)(buf); unsigned keep_; \
    asm volatile("s_mov_b32 %0, m0\n\t" \
      "s_add_u32 m0, %7, 0\n\ts_nop 0\n\tglobal_load_lds_dwordx4 %1, %3\n\t" \
      "s_add_u32 m0, %7, 1024\n\ts_nop 0\n\tglobal_load_lds_dwordx4 %2, %4\n\t" \
      "s_add_u32 m0, %7, 2048\n\ts_nop 0\n\tglobal_load_lds_dwordx4 %1, %5\n\t" \
      "s_add_u32 m0, %7, 3072\n\ts_nop 0\n\tglobal_load_lds_dwordx4 %2, %6\n\t" \
      "s_mov_b32 m0, %0" : "=&s"(keep_) : "v"(kofs0), "v"(kofs1), "s"(kb0_), "s"(kb1_), "s"(kb2_), "s"(kb3_), "s"(lk_) : "memory", "scc"); } while (0)
#define ISSUE_V(buf, k0) do { const char* vb0_ = (const char*)Vh + (size_t)(k0) * (LDK * 2); const char* vb1_ = vb0_ + 4 * LDK * 2; \
    const unsigned lv_ = ldsv0 + (buf) * 32768u; unsigned keep_; \
    asm volatile("s_mov_b32 %0, m0\n\t" \
      "s_add_u32 m0, %4, 0\n\ts_nop 0\n\tglobal_load_lds_dwordx4 %1, %2\n\t" \
      "s_add_u32 m0, %4, 16128\n\ts_nop 0\n\tglobal_load_lds_dwordx4 %1, %2 offset:256\n\t" \
      "s_add_u32 m0, %4, 896\n\ts_nop 0\n\tglobal_load_lds_dwordx4 %1, %2 offset:128\n\t" \
      "s_add_u32 m0, %4, 17024\n\ts_nop 0\n\tglobal_load_lds_dwordx4 %1, %2 offset:384\n\t" \
      "s_add_u32 m0, %4, 2048\n\ts_nop 0\n\tglobal_load_lds_dwordx4 %1, %3\n\t" \
      "s_add_u32 m0, %4, 18176\n\ts_nop 0\n\tglobal_load_lds_dwordx4 %1, %3 offset:256\n\t" \
      "s_add_u32 m0, %4, 2944\n\ts_nop 0\n\tglobal_load_lds_dwordx4 %1, %3 offset:128\n\t" \
      "s_add_u32 m0, %4, 19072\n\ts_nop 0\n\tglobal_load_lds_dwordx4 %1, %3 offset:384\n\t" \
      "s_mov_b32 m0, %0" : "=&s"(keep_) : "v"(vofs), "s"(vb0_), "s"(vb1_), "s"(lv_) : "memory", "scc"); } while (0)
  const int vbase = (int)(uintptr_t)(lds + VB0) + v_rd_base(lane);
  int kaddr[4];
#pragma unroll
  for (int d0 = 0; d0 < 4; ++d0) kaddr[d0] = (int)(uintptr_t)lds + r32 * 256 + ((d0 * 32 + hi * 16) ^ ((r32 & 7) << 4));
  const int NT = seq / KVBLK;
  constexpr float THR2 = THR * 1.4426950408889634f;
#define KWAIT(n) do { asm volatile("s_waitcnt lgkmcnt(" #n ")" ::: "memory"); SBAR(); } while (0)
#define KLOAD1(kf, buf, d0) do { kf[0] = k_read<((d0) >> 2) * 128>(ka[(d0) & 3]); kf[1] = k_read<8192 + ((d0) >> 2) * 128>(ka[(d0) & 3]); } while (0)
#define KMMA1(kf, d0) do { p0 = __builtin_amdgcn_mfma_f32_32x32x16_bf16(kf[0], qr[d0], p0, 0, 0, 0); p1 = __builtin_amdgcn_mfma_f32_32x32x16_bf16(kf[1], qr[d0], p1, 0, 0, 0); \
      asm volatile("" : "+v"(p0), "+v"(p1)); } while (0)
#define PKV(L, H) (bf16x8){L[0], L[1], L[2], L[3], H[0], H[1], H[2], H[3]}
#define WGBAR() do { asm volatile("" ::: "memory"); __builtin_amdgcn_s_barrier(); asm volatile("" ::: "memory"); } while (0)
#define QKT(KBUF) do { int ka[4]; _Pragma("unroll") for (int d = 0; d < 4; ++d) ka[d] = kaddr[d] + (KBUF); _Pragma("unroll") for (int r = 0; r < 16; ++r) { p0[r] = 0.f; p1[r] = 0.f; } \
    { bf16x8 k0[2], k1[2], k2[2]; \
      KLOAD1(k0, KBUF, 0); KLOAD1(k1, KBUF, 1); KLOAD1(k2, KBUF, 2); \
      KWAIT(4); KMMA1(k0, 0); KLOAD1(k0, KBUF, 3); \
      KWAIT(4); KMMA1(k1, 1); KLOAD1(k1, KBUF, 4); \
      KWAIT(4); KMMA1(k2, 2); KLOAD1(k2, KBUF, 5); \
      KWAIT(4); KMMA1(k0, 3); KLOAD1(k0, KBUF, 6); \
      KWAIT(4); KMMA1(k1, 4); KLOAD1(k1, KBUF, 7); \
      KWAIT(4); KMMA1(k2, 5); \
      KWAIT(2); KMMA1(k0, 6); \
      KWAIT(0); KMMA1(k1, 7); } \
  } while (0)
#define TILE(buf, t) do { \
      \
    if (grp == 1) { if ((t) + 1 < NT) ISSUE_V(1 - (buf), ((t) + 1) * KVBLK); } else if ((t) + 2 < NT) ISSUE_K(kq == 32768 ? 0 : kq + 16384, ((t) + 2) * KVBLK);   \
    float pmax = p0[0]; \
    _Pragma("unroll") for (int r = 1; r < 16; ++r) pmax = fmaxf(pmax, p0[r]); \
    _Pragma("unroll") for (int r = 0; r < 16; ++r) pmax = fmaxf(pmax, p1[r]); \
    { auto rr = __builtin_amdgcn_permlane32_swap(__float_as_uint(pmax), __float_as_uint(pmax), false, false); pmax = fmaxf(__uint_as_float(rr[0]), __uint_as_float(rr[1])); } \
    float alpha = 1.f; \
    { const bool ok_ = ((t) > 0) ? __all(pmax - m_reg <= THR2) : __all(fabsf(pmax) <= THR2); \
      if (!__builtin_expect(ok_, 1)) { const float mn = ((t) > 0) ? fmaxf(m_reg, pmax) : pmax; alpha = ((t) > 0) ? __builtin_amdgcn_exp2f(m_reg - mn) : 1.f; m_reg = mn; } } \
    float ps = 0.f; \
    if (!__builtin_expect(__all(m_reg == 0.f), 1)) { \
      _Pragma("unroll") for (int r = 0; r < 16; ++r) { p0[r] -= m_reg; p1[r] -= m_reg; } } \
    _Pragma("unroll") for (int r = 0; r < 16; ++r) { p0[r] = __builtin_amdgcn_exp2f(p0[r]); ps += p0[r]; } \
    _Pragma("unroll") for (int r = 0; r < 16; ++r) { p1[r] = __builtin_amdgcn_exp2f(p1[r]); ps += p1[r]; } \
    { auto rr = __builtin_amdgcn_permlane32_swap(__float_as_uint(ps), __float_as_uint(ps), false, false); ps = __uint_as_float(rr[0]) + __uint_as_float(rr[1]); } \
    l_reg = l_reg * alpha + ps; \
    bf16x8 pa0, pa1, pa2, pa3; \
    PK4(p0, 0, pa0); PK4(p0, 8, pa1); PK4(p1, 0, pa2); PK4(p1, 8, pa3); \
    if (grp == 0) { if ((t) + 2 < NT) asm volatile("s_waitcnt vmcnt(4)" ::: "memory"); else asm volatile("s_waitcnt vmcnt(0)" ::: "memory"); }     \
    WGBAR(); \
      \
    if (__any(alpha < 1.f)) { if (hi == 0) al_l[r32] = alpha; asm volatile("s_waitcnt lgkmcnt(0)" ::: "memory"); \
      _Pragma("unroll") for (int r = 0; r < 16; ++r) { const float a_ = al_l[crow(r, hi)]; _Pragma("unroll") for (int d = 0; d < 8; ++d) o[d][r] *= a_; } } \
    const int vb_r = vbase + (buf) * 32768; \
    { s16x4 vl[4], vh[4]; \
      vl[0] = tr_read<0>(vb_r); vh[0] = tr_read<2048>(vb_r); vl[1] = tr_read<4096>(vb_r); vh[1] = tr_read<6144>(vb_r); vl[2] = tr_read<8192>(vb_r); vh[2] = tr_read<10240>(vb_r); \
      vl[3] = tr_read<12288>(vb_r); vh[3] = tr_read<14336>(vb_r); KWAIT(6); o[0] = __builtin_amdgcn_mfma_f32_32x32x16_bf16(pa0, PKV(vl[0], vh[0]), o[0], 0, 0, 0); \
      vl[0] = tr_read<512>(vb_r); vh[0] = tr_read<2560>(vb_r); KWAIT(6); o[0] = __builtin_amdgcn_mfma_f32_32x32x16_bf16(pa1, PKV(vl[1], vh[1]), o[0], 0, 0, 0); \
      vl[1] = tr_read<4608>(vb_r); vh[1] = tr_read<6656>(vb_r); KWAIT(6); o[0] = __builtin_amdgcn_mfma_f32_32x32x16_bf16(pa2, PKV(vl[2], vh[2]), o[0], 0, 0, 0); \
      vl[2] = tr_read<8704>(vb_r); vh[2] = tr_read<10752>(vb_r); KWAIT(6); o[0] = __builtin_amdgcn_mfma_f32_32x32x16_bf16(pa3, PKV(vl[3], vh[3]), o[0], 0, 0, 0); \
      vl[3] = tr_read<12800>(vb_r); vh[3] = tr_read<14848>(vb_r); KWAIT(6); o[1] = __builtin_amdgcn_mfma_f32_32x32x16_bf16(pa0, PKV(vl[0], vh[0]), o[1], 0, 0, 0); \
      vl[0] = tr_read<1024>(vb_r); vh[0] = tr_read<3072>(vb_r); KWAIT(6); o[1] = __builtin_amdgcn_mfma_f32_32x32x16_bf16(pa1, PKV(vl[1], vh[1]), o[1], 0, 0, 0); \
      vl[1] = tr_read<5120>(vb_r); vh[1] = tr_read<7168>(vb_r); KWAIT(6); o[1] = __builtin_amdgcn_mfma_f32_32x32x16_bf16(pa2, PKV(vl[2], vh[2]), o[1], 0, 0, 0); \
      vl[2] = tr_read<9216>(vb_r); vh[2] = tr_read<11264>(vb_r); KWAIT(6); o[1] = __builtin_amdgcn_mfma_f32_32x32x16_bf16(pa3, PKV(vl[3], vh[3]), o[1], 0, 0, 0); \
      vl[3] = tr_read<13312>(vb_r); vh[3] = tr_read<15360>(vb_r); KWAIT(6); o[2] = __builtin_amdgcn_mfma_f32_32x32x16_bf16(pa0, PKV(vl[0], vh[0]), o[2], 0, 0, 0); \
      vl[0] = tr_read<1536>(vb_r); vh[0] = tr_read<3584>(vb_r); KWAIT(6); o[2] = __builtin_amdgcn_mfma_f32_32x32x16_bf16(pa1, PKV(vl[1], vh[1]), o[2], 0, 0, 0); \
      vl[1] = tr_read<5632>(vb_r); vh[1] = tr_read<7680>(vb_r); KWAIT(6); o[2] = __builtin_amdgcn_mfma_f32_32x32x16_bf16(pa2, PKV(vl[2], vh[2]), o[2], 0, 0, 0); \
      vl[2] = tr_read<9728>(vb_r); vh[2] = tr_read<11776>(vb_r); KWAIT(6); o[2] = __builtin_amdgcn_mfma_f32_32x32x16_bf16(pa3, PKV(vl[3], vh[3]), o[2], 0, 0, 0); \
      vl[3] = tr_read<13824>(vb_r); vh[3] = tr_read<15872>(vb_r); KWAIT(6); o[3] = __builtin_amdgcn_mfma_f32_32x32x16_bf16(pa0, PKV(vl[0], vh[0]), o[3], 0, 0, 0); \
      vl[0] = tr_read<16384>(vb_r); vh[0] = tr_read<18432>(vb_r); KWAIT(6); o[3] = __builtin_amdgcn_mfma_f32_32x32x16_bf16(pa1, PKV(vl[1], vh[1]), o[3], 0, 0, 0); \
      vl[1] = tr_read<20480>(vb_r); vh[1] = tr_read<22528>(vb_r); KWAIT(6); o[3] = __builtin_amdgcn_mfma_f32_32x32x16_bf16(pa2, PKV(vl[2], vh[2]), o[3], 0, 0, 0); \
      vl[2] = tr_read<24576>(vb_r); vh[2] = tr_read<26624>(vb_r); KWAIT(6); o[3] = __builtin_amdgcn_mfma_f32_32x32x16_bf16(pa3, PKV(vl[3], vh[3]), o[3], 0, 0, 0); \
      vl[3] = tr_read<28672>(vb_r); vh[3] = tr_read<30720>(vb_r); KWAIT(6); o[4] = __builtin_amdgcn_mfma_f32_32x32x16_bf16(pa0, PKV(vl[0], vh[0]), o[4], 0, 0, 0); \
      vl[0] = tr_read<16896>(vb_r); vh[0] = tr_read<18944>(vb_r); KWAIT(6); o[4] = __builtin_amdgcn_mfma_f32_32x32x16_bf16(pa1, PKV(vl[1], vh[1]), o[4], 0, 0, 0); \
      vl[1] = tr_read<20992>(vb_r); vh[1] = tr_read<23040>(vb_r); KWAIT(6); o[4] = __builtin_amdgcn_mfma_f32_32x32x16_bf16(pa2, PKV(vl[2], vh[2]), o[4], 0, 0, 0); \
      vl[2] = tr_read<25088>(vb_r); vh[2] = tr_read<27136>(vb_r); KWAIT(6); o[4] = __builtin_amdgcn_mfma_f32_32x32x16_bf16(pa3, PKV(vl[3], vh[3]), o[4], 0, 0, 0); \
      vl[3] = tr_read<29184>(vb_r); vh[3] = tr_read<31232>(vb_r); KWAIT(6); o[5] = __builtin_amdgcn_mfma_f32_32x32x16_bf16(pa0, PKV(vl[0], vh[0]), o[5], 0, 0, 0); \
      vl[0] = tr_read<17408>(vb_r); vh[0] = tr_read<19456>(vb_r); KWAIT(6); o[5] = __builtin_amdgcn_mfma_f32_32x32x16_bf16(pa1, PKV(vl[1], vh[1]), o[5], 0, 0, 0); \
      vl[1] = tr_read<21504>(vb_r); vh[1] = tr_read<23552>(vb_r); KWAIT(6); o[5] = __builtin_amdgcn_mfma_f32_32x32x16_bf16(pa2, PKV(vl[2], vh[2]), o[5], 0, 0, 0); \
      vl[2] = tr_read<25600>(vb_r); vh[2] = tr_read<27648>(vb_r); KWAIT(6); o[5] = __builtin_amdgcn_mfma_f32_32x32x16_bf16(pa3, PKV(vl[3], vh[3]), o[5], 0, 0, 0); \
      vl[3] = tr_read<29696>(vb_r); vh[3] = tr_read<31744>(vb_r); KWAIT(6); o[6] = __builtin_amdgcn_mfma_f32_32x32x16_bf16(pa0, PKV(vl[0], vh[0]), o[6], 0, 0, 0); \
      vl[0] = tr_read<17920>(vb_r); vh[0] = tr_read<19968>(vb_r); KWAIT(6); o[6] = __builtin_amdgcn_mfma_f32_32x32x16_bf16(pa1, PKV(vl[1], vh[1]), o[6], 0, 0, 0); \
      vl[1] = tr_read<22016>(vb_r); vh[1] = tr_read<24064>(vb_r); KWAIT(6); o[6] = __builtin_amdgcn_mfma_f32_32x32x16_bf16(pa2, PKV(vl[2], vh[2]), o[6], 0, 0, 0); \
      vl[2] = tr_read<26112>(vb_r); vh[2] = tr_read<28160>(vb_r); KWAIT(6); o[6] = __builtin_amdgcn_mfma_f32_32x32x16_bf16(pa3, PKV(vl[3], vh[3]), o[6], 0, 0, 0); \
      vl[3] = tr_read<30208>(vb_r); vh[3] = tr_read<32256>(vb_r); KWAIT(6); o[7] = __builtin_amdgcn_mfma_f32_32x32x16_bf16(pa0, PKV(vl[0], vh[0]), o[7], 0, 0, 0); \
      KWAIT(4); o[7] = __builtin_amdgcn_mfma_f32_32x32x16_bf16(pa1, PKV(vl[1], vh[1]), o[7], 0, 0, 0); \
      KWAIT(2); o[7] = __builtin_amdgcn_mfma_f32_32x32x16_bf16(pa2, PKV(vl[2], vh[2]), o[7], 0, 0, 0); \
      KWAIT(0); o[7] = __builtin_amdgcn_mfma_f32_32x32x16_bf16(pa3, PKV(vl[3], vh[3]), o[7], 0, 0, 0); \
    } \
    SBAR(); QKT(kq); kq = (kq == 32768 ? 0 : kq + 16384);   \
    if (grp == 1) asm volatile("s_waitcnt vmcnt(0)" ::: "memory"); \
    WGBAR(); \
  } while (0)
#define PK4(P, BASE, OUT) do { unsigned a0 = cvtpk(P[BASE + 0], P[BASE + 1]), a1 = cvtpk(P[BASE + 2], P[BASE + 3]);   \
    unsigned b0 = cvtpk(P[BASE + 4], P[BASE + 5]), b1 = cvtpk(P[BASE + 6], P[BASE + 7]);                              \
    auto r0 = __builtin_amdgcn_permlane32_swap(a0, b0, false, false); auto r1 = __builtin_amdgcn_permlane32_swap(a1, b1, false, false); \
    v4u w = {r0[0], r1[0], r0[1], r1[1]}; OUT = *reinterpret_cast<bf16x8*>(&w); } while (0)
  if (grp == 0) { ISSUE_K(0, 0); ISSUE_K(16384, KVBLK); } else ISSUE_V(0, 0);
  asm volatile("s_waitcnt vmcnt(0)" ::: "memory"); WGBAR();
  f32x16 p0, p1;
  QKT(0);
  int kq = 16384;
  if (grp == 1) WGBAR();
  for (int t = 0; t < NT; t += 2) { TILE(0, t); TILE(1, t + 1); }
  if (grp == 0) WGBAR();
#undef QKT
#undef PK4
#undef TILE
#undef ISSUE_K
#undef ISSUE_V
#undef KLOAD1
#undef KMMA1
#undef KWAIT
#undef PKV
#undef WGBAR
  if (hi == 0) li_l[r32] = l_reg; asm volatile("s_waitcnt lgkmcnt(0)" ::: "memory");
  float rli[16];
#pragma unroll
  for (int r = 0; r < 16; ++r) rli[r] = __builtin_amdgcn_rcpf(li_l[crow(r, hi)]);
  float* Ow = Ob + (long)(wid * 32) * LDO;
  if (!fin) {
#pragma unroll
    for (int r = 0; r < 16; ++r) { const int orow = crow(r, hi);
#pragma unroll
      for (int d0 = 0; d0 < 8; ++d0) Ow[(long)orow * LDO + d0 * 32 + r32] = o[d0][r] * rli[r]; }
  } else {
    const LAS float* cst = (const LAS float*)(lds + CST);
    const float lam = cst[256]; float sg[8];
#pragma unroll
    for (int d0 = 0; d0 < 8; ++d0) sg[d0] = cst[d0 * 32 + r32];
    unsigned char* wsb = *(unsigned char* const __attribute__((address_space(4)))*)((const __attribute__((address_space(4))) char*)__builtin_amdgcn_kernarg_segment_ptr() + 184);
    bf16* Ab = (bf16*)(wsb + A_ATTN + (((const unsigned char*)Ob - (wsb + A_OP) - 1024) >> 2));
    bf16* Aw = Ab + (long)(wid * 32) * 2048;
#pragma unroll
    for (int r = 0; r < 16; ++r) { const int orow = crow(r, hi); float ss = 0.f;
#pragma unroll
      for (int d0 = 0; d0 < 8; ++d0) { const float d = o[d0][r] * rli[r] - lam * Ow[(long)orow * LDO + d0 * 32 + r32]; o[d0][r] = d; ss += d * d; }
      ss += __shfl_xor(ss, 1); ss += __shfl_xor(ss, 2); ss += __shfl_xor(ss, 4); ss += __shfl_xor(ss, 8); ss += __shfl_xor(ss, 16);
      const float rs = 1.0f / sqrtf(ss * (1.f / 256.f) + LN_EPS);
#pragma unroll
      for (int d0 = 0; d0 < 8; ++d0) Aw[(long)orow * 2048 + d0 * 32 + r32] = (bf16)f2bf(o[d0][r] * rs * sg[d0]); }
  }
}
}

constexpr int NWAVES = 8, NPH = 13;
constexpr int RING_BYTES = 131072, MISC_OFF = 143360, LDS_BYTES = 147456;

struct Args { const float* in[22]; float* out; unsigned char* ws; int ph_lo, ph_hi; };
static_assert(sizeof(Args) == 22 * 8 + 8 + 8 + 8, "no padding");
static_assert(offsetof(Args, ws) == 184, "att2's final-pass epilogue re-reads Args::ws at byte 184 of the kernel arguments");

__device__ __forceinline__ void ln_row(const float* in, const float* gam, const float* bet, float* outf, bf16* outb, f32x2* stat, int lane) {
    const GAS f32x4* xr = (const GAS f32x4*)in + lane;
    f32x4 v[16]; float s = 0.f;
#pragma unroll
    for (int j = 0; j < 16; ++j) { v[j] = xr[64 * j]; s += (v[j].x + v[j].y) + (v[j].z + v[j].w); }
    const float mean = wave_sum(s) * (1.f / DM); float s2 = 0.f;
#pragma unroll
    for (int j = 0; j < 16; ++j) { v[j] = v[j] - mean; s2 += (v[j].x * v[j].x + v[j].y * v[j].y) + (v[j].z * v[j].z + v[j].w * v[j].w); }
    const float rstd = 1.f / sqrtf(wave_sum(s2) * (1.f / DM) + LN_EPS);
    if (stat && lane == 0) *stat = (f32x2){mean, rstd};
    const GAS f32x4* gr = (const GAS f32x4*)gam + lane; const GAS f32x4* br = (const GAS f32x4*)bet + lane;
    GAS f32x4* of = (GAS f32x4*)outf + lane; GAS v2u* ob = (GAS v2u*)outb + lane;
#pragma unroll
    for (int j = 0; j < 16; ++j) { const f32x4 o = v[j] * rstd * gr[64 * j] + br[64 * j]; if (outf) of[64 * j] = o;
        if (outb) { v2u w; w.x = pk2(o.x, o.y); w.y = pk2(o.z, o.w); ob[64 * j] = w; } }
}
__device__ __forceinline__ void ln_rows_f(const float* in, const float* gam, const float* bet, bf16* outb, f32x2* stat, int first, int step, int lane) {
    if (first >= M) return;
    f32x4 nx[16];
    { const GAS f32x4* xr = (const GAS f32x4*)(in + (size_t)first * DM) + lane;
#pragma unroll
      for (int j = 0; j < 16; ++j) nx[j] = xr[64 * j]; }
    const GAS f32x4* gr = (const GAS f32x4*)gam + lane; const GAS f32x4* br = (const GAS f32x4*)bet + lane;
    for (int m = first; m < M; m += step) {
        f32x4 v[16]; float s = 0.f;
#pragma unroll
        for (int j = 0; j < 16; ++j) { v[j] = nx[j]; s += (v[j].x + v[j].y) + (v[j].z + v[j].w); }
        { const int mn = m + step < M ? m + step : m; const GAS f32x4* xr = (const GAS f32x4*)(in + (size_t)mn * DM) + lane;
#pragma unroll
          for (int j = 0; j < 16; ++j) nx[j] = xr[64 * j]; }
        const float mean = wave_sum(s) * (1.f / DM); float s2 = 0.f;
#pragma unroll
        for (int j = 0; j < 16; ++j) { v[j] = v[j] - mean; s2 += (v[j].x * v[j].x + v[j].y * v[j].y) + (v[j].z * v[j].z + v[j].w * v[j].w); }
        const float rstd = 1.f / sqrtf(wave_sum(s2) * (1.f / DM) + LN_EPS);
        if (lane == 0) stat[m] = (f32x2){mean, rstd};
        GAS v2u* ob = (GAS v2u*)(outb + (size_t)m * DM) + lane;
#pragma unroll
        for (int j = 0; j < 16; ++j) { const f32x4 o = v[j] * rstd * gr[64 * j] + br[64 * j]; v2u w; w.x = pk2(o.x, o.y); w.y = pk2(o.z, o.w); ob[64 * j] = w; }
    }
}
__device__ __forceinline__ void ln_rows_h(const _Float16* in, const float* gam, const float* bet, float* outf, bf16* outb, f32x2* stat, int first, int step, int lane) {
    if (first >= M) return;
    f32x4 g[16], b[16];
    { const GAS f32x4* gr = (const GAS f32x4*)gam + 2 * lane; const GAS f32x4* br = (const GAS f32x4*)bet + 2 * lane;
#pragma unroll
      for (int j = 0; j < 8; ++j) { g[2 * j] = gr[128 * j]; g[2 * j + 1] = gr[128 * j + 1]; b[2 * j] = br[128 * j]; b[2 * j + 1] = br[128 * j + 1]; } }
    h16x8 raw[8];
    { const GAS h16x8* xr = (const GAS h16x8*)(in + (size_t)first * DM) + lane;
#pragma unroll
      for (int j = 0; j < 8; ++j) raw[j] = xr[64 * j]; }
    for (int m = first; m < M; m += step) {
        f32x4 v[16]; float s = 0.f;
#pragma unroll
        for (int j = 0; j < 8; ++j) { const h16x8 h = raw[j];
            v[2 * j] = __builtin_convertvector(__builtin_shufflevector(h, h, 0, 1, 2, 3), f32x4); v[2 * j + 1] = __builtin_convertvector(__builtin_shufflevector(h, h, 4, 5, 6, 7), f32x4);
            s += ((v[2 * j].x + v[2 * j].y) + (v[2 * j].z + v[2 * j].w)) + ((v[2 * j + 1].x + v[2 * j + 1].y) + (v[2 * j + 1].z + v[2 * j + 1].w)); }
        { const int mn = m + step < M ? m + step : m; const GAS h16x8* xr = (const GAS h16x8*)(in + (size_t)mn * DM) + lane;
#pragma unroll
          for (int j = 0; j < 8; ++j) raw[j] = xr[64 * j]; }
        const float mean = wave_sum(s) * (1.f / DM); float s2 = 0.f;
#pragma unroll
        for (int j = 0; j < 16; ++j) { v[j] = v[j] - mean; s2 += (v[j].x * v[j].x + v[j].y * v[j].y) + (v[j].z * v[j].z + v[j].w * v[j].w); }
        const float rstd = 1.f / sqrtf(wave_sum(s2) * (1.f / DM) + LN_EPS);
        if (stat && lane == 0) stat[m] = (f32x2){mean, rstd};
        GAS f32x4* of = (GAS f32x4*)(outf + (size_t)m * DM) + 2 * lane; GAS v4u* ob = (GAS v4u*)(outb + (size_t)m * DM) + lane;
#pragma unroll
        for (int j = 0; j < 8; ++j) { const f32x4 o0 = v[2 * j] * rstd * g[2 * j] + b[2 * j], o1 = v[2 * j + 1] * rstd * g[2 * j + 1] + b[2 * j + 1];
            if (outf) { of[128 * j] = o0; of[128 * j + 1] = o1; }
            if (outb) { v4u w; w.x = pk2(o0.x, o0.y); w.y = pk2(o0.z, o0.w); w.z = pk2(o1.x, o1.y); w.w = pk2(o1.z, o1.w); ob[64 * j] = w; } }
    }
}
__device__ __forceinline__ void transpose_item(const float* W, int K, int N, bf16* WT, int k0, int n0, int drow0, LAS float* scr, int lane) {
    const int lk = lane >> 4, ln = (lane & 15) * 4;
    const GAS float* src = (const GAS float*)W + (size_t)(k0 + lk) * N + n0 + ln;
    f32x4 v[16];
#pragma unroll
    for (int i = 0; i < 16; ++i) v[i] = *(const GAS f32x4*)(src + (size_t)(4 * i) * N);
#pragma unroll
    for (int i = 0; i < 16; ++i) { LAS float* d = scr + (4 * i + lk) * 65 + ln; d[0] = v[i].x; d[1] = v[i].y; d[2] = v[i].z; d[3] = v[i].w; }
    LDS_WAIT(); asm volatile("" ::: "memory");
    const int c = lane & 7;
#pragma unroll
    for (int j = 0; j < 8; ++j) { const int n = (lane >> 3) + 8 * j; const LAS float* s = scr + (8 * c) * 65 + n;
        v4u o; o.x = pk2(s[0 * 65], s[1 * 65]); o.y = pk2(s[2 * 65], s[3 * 65]); o.z = pk2(s[4 * 65], s[5 * 65]); o.w = pk2(s[6 * 65], s[7 * 65]);
        *(GAS v4u*)(WT + (size_t)(drow0 + n) * K + k0 + 8 * c) = o; }
    LDS_WAIT(); asm volatile("" ::: "memory");
}
struct TItem { const GAS float* src; GAS bf16* dst; int N, K; };
__device__ __forceinline__ TItem titem_make(const float* W, int K, int N, bf16* WT, int k0, int n0, int drow0, int lane) {
    TItem P; P.src = (const GAS float*)W + (size_t)(k0 + 2 * (lane >> 4)) * N + n0 + (lane & 15) * 4;
    P.dst = (GAS bf16*)WT + (size_t)(drow0 + (lane >> 3)) * K + k0 + 8 * (lane & 7); P.N = N; P.K = K; return P;
}
__device__ __forceinline__ void titem_load(const TItem& P, f32x4 (&v)[16]) {
#pragma unroll
    for (int a = 0; a < 8; ++a) { v[2 * a] = *(const GAS f32x4*)(P.src + (size_t)(8 * a) * P.N); v[2 * a + 1] = *(const GAS f32x4*)(P.src + (size_t)(8 * a + 1) * P.N); }
}
__device__ __forceinline__ void titem_finish(const TItem& P, const f32x4 (&v)[16], LAS float* scrf, int lane) {
    LAS unsigned* scr = (LAS unsigned*)scrf;
    const int lk = lane >> 4, ln = (lane & 15) * 4;
#pragma unroll
    for (int a = 0; a < 8; ++a) { LAS unsigned* d = scr + (4 * a + lk) * 66 + ln;
        v2u w0, w1; w0.x = pk2(v[2 * a].x, v[2 * a + 1].x); w0.y = pk2(v[2 * a].y, v[2 * a + 1].y); w1.x = pk2(v[2 * a].z, v[2 * a + 1].z); w1.y = pk2(v[2 * a].w, v[2 * a + 1].w);
        *(LAS v2u*)d = w0; *(LAS v2u*)(d + 2) = w1; }
    LDS_WAIT(); asm volatile("" ::: "memory");
    const int c = lane & 7;
#pragma unroll
    for (int j = 0; j < 8; ++j) { const LAS unsigned* s = scr + (4 * c) * 66 + (lane >> 3) + 8 * j;
        v4u o; o.x = s[0]; o.y = s[66]; o.z = s[132]; o.w = s[198];
        *(GAS v4u*)(P.dst + (size_t)(8 * j) * P.K) = o; }
    LDS_WAIT(); asm volatile("" ::: "memory");
}
__constant__ float INV_FREQ[16] = {1.0f, 0.440366596f, 0.193922743f, 0.0853971019f, 0.0376060307f, 0.016560439f, 0.00729266461f, 0.00321144587f,
                                   0.00141421356f, 0.000622772379f, 0.000274248188f, 0.000120769735f, 5.3182961e-05f, 2.34199997e-05f, 1.03133862e-05f, 4.54167048e-06f};
constexpr float W32C[16] = {1.0f, 0.980785251f, 0.923879504f, 0.831469595f, 0.707106769f, 0.555570245f, 0.382683426f, 0.195090324f, 0.0f, -0.195090324f, -0.382683426f, -0.555570245f, -0.707106769f, -0.831469595f, -0.923879504f, -0.980785251f};
constexpr float W32S[16] = {0.0f, 0.195090324f, 0.382683426f, 0.555570245f, 0.707106769f, 0.831469595f, 0.923879504f, 0.980785251f, 1.0f, 0.980785251f, 0.923879504f, 0.831469595f, 0.707106769f, 0.555570245f, 0.382683426f, 0.195090324f};

__device__ __forceinline__ int rep_fence() { asm volatile("s_nop 0" ::: "memory"); return 1; }
__global__ void __launch_bounds__(NWAVES * 64, 2) fwd(Args args) {
    extern __shared__ __attribute__((aligned(16))) unsigned char lds[];
    LAS unsigned char* L = (LAS unsigned char*)lds;
    volatile LAS unsigned* MISC = (volatile LAS unsigned*)(L + MISC_OFF);
    int wave = __builtin_amdgcn_readfirstlane(threadIdx.x >> 6); asm volatile("" : "+s"(wave));
    const int G = gridDim.x, bx = blockIdx.x;
    const int gw = bx * NWAVES + wave, NGW = G * NWAVES;
    const int NGT = G * NWAVES * 64;
#define LATE_DECODE(itv, P) do { int r = (itv); \
            if (r < I_AO) { const int kb = r % 32, nb = r / 32; P = titem_make(w_attn_o, 2048, 4096, WaoT, 64 * kb, 64 * nb, 64 * nb, lane_c); break; } r -= I_AO; \
            if (r < I_FO) { const int kb = r % 32, nb = r / 32; P = titem_make(w_fourier, 2048, 4096, WfT, 64 * kb, 64 * nb, 64 * nb, lane_c); break; } r -= I_FO; \
            if (r < I_G) { const int kb = r % 64, nb = r / 64; const int n0 = 64 * nb, half = n0 >> 12, j = n0 & 4095; const int dr = (j >> 7) * 256 + half * 128 + (j & 127); \
                           P = titem_make(w_gate, 4096, 8192, WgT, 64 * kb, n0, dr, lane_c); break; } r -= I_G; \
            if (r < I_MX) { const int kb = r % 64, nb = r / 64; P = titem_make(w_mix_out, 4096, 4096, WmT, 64 * kb, 64 * nb, 64 * nb, lane_c); break; } r -= I_MX; \
            { const int kb = r % 64, nb = r / 64; const int n0 = 64 * nb, half = n0 >= DFF ? 1 : 0, j = n0 - half * DFF; const int dr = (j >> 7) * 256 + half * 128 + (j & 127); \
                            P = titem_make(w_up, 4096, DFF2, WupT, 64 * kb, n0, dr, lane_c); } \
    } while (0)
#define LATE_CONVERT() do { \
        __syncthreads(); const int lane_c = lane_id_fresh(); LAS float* scr = (LAS float*)(L + wave * 17408); \
        constexpr int I_AO = 32 * 64, I_FO = 32 * 64, I_G = 64 * 128, I_MX = 64 * 64, I_UP = 64 * 344; \
        constexpr int NITEMS = I_AO + I_FO + I_G + I_MX + I_UP; \
        int it = gw; asm volatile("" : "+s"(it));   \
        if (it < NITEMS) { \
            TItem P; f32x4 v[16]; LATE_DECODE(it, P); titem_load(P, v); \
            for (;;) { \
                const int it2 = it + NGW; const bool more = it2 < NITEMS; \
                TItem P2; f32x4 v2[16]; LATE_DECODE(more ? it2 : it, P2); titem_load(P2, v2); \
                titem_finish(P, v, scr, lane_c); \
                if (!more) break; \
                P = P2; it = it2; \
                _Pragma("unroll") for (int i = 0; i < 16; ++i) v[i] = v2[i]; \
            } \
        } \
        asm volatile("s_waitcnt vmcnt(0)" ::: "memory"); __syncthreads(); \
    } while (0)
#define PHASE_LANES() const int lane = lane_id_fresh(); const int tid = wave * 64 + lane; const int gt = bx * NWAVES * 64 + tid; (void)tid; (void)gt; (void)lane
#define KARG ((const __attribute__((address_space(4))) Args*)__builtin_amdgcn_kernarg_segment_ptr())
#define WSB (KARG->ws)
#define OUT (KARG->out)
#define x_in (KARG->in[0])
#define ln_emb_g (KARG->in[1])
#define ln_emb_b (KARG->in[2])
#define w_in (KARG->in[3])
#define lq1 (KARG->in[4])
#define lk1 (KARG->in[5])
#define lq2 (KARG->in[6])
#define lk2 (KARG->in[7])
#define subln_g (KARG->in[8])
#define w_attn_o (KARG->in[9])
#define w_fourier (KARG->in[10])
#define w_gate (KARG->in[11])
#define b_gate (KARG->in[12])
#define w_mix_out (KARG->in[13])
#define ln1_g (KARG->in[14])
#define ln1_b (KARG->in[15])
#define w_up (KARG->in[16])
#define conv_w (KARG->in[17])
#define conv_b (KARG->in[18])
#define w_down (KARG->in[19])
#define ln2_g (KARG->in[20])
#define ln2_b (KARG->in[21])
#define WdT ((bf16*)(WSB + W_DT))
#define WmT ((bf16*)(WSB + W_MT))
#define WaoT ((bf16*)(WSB + W_AOT))
#define WfT ((bf16*)(WSB + W_FT))
#define WgT ((bf16*)(WSB + W_GT))
#define WinT ((bf16*)(WSB + W_INT))
#define WupT ((bf16*)(WSB + W_UPT))
#define DFT256 ((bf16*)(WSB + TAB_DFT256))
#define DFTC ((bf16*)(WSB + TAB_DFTC))
#define TW ((f32x2*)(WSB + TAB_TW))
#define ROPEC ((float*)(WSB + TAB_ROPEC))
#define ROPES ((float*)(WSB + TAB_ROPES))
#define HB ((bf16*)(WSB + A_HB))
#define UQKV ((bf16*)(WSB + A_UQKV))
#define UFT ((bf16*)(WSB + A_UFT))
#define TT ((bf16*)(WSB + A_T))
#define OP ((float*)(WSB + A_OP))
#define ZT ((bf16*)(WSB + A_ZT))
#define ATTN ((bf16*)(WSB + A_ATTN))
#define YF ((bf16*)(WSB + A_YF))
#define YA ((bf16*)(WSB + A_YA))
#define YFO ((bf16*)(WSB + A_YFO))
#define MIX ((bf16*)(WSB + A_MIX))
#define R1H ((_Float16*)(WSB + A_R1H))
#define R2H ((_Float16*)(WSB + A_R2H))
#define ABUF ((bf16*)(WSB + A_A))
#define ACT ((bf16*)(WSB + WS_ACT))

    { const int l0 = lane_id_fresh(); if (wave == 0 && l0 < 8) MISC[l0] = 0u; }
    __syncthreads();
    XcdBarrier bar; bar.bar = (unsigned*)(WSB + WS_CTL) + CW_BAR; bar.x = 0; bar.st = nullptr;
    if (!MK_PER_PHASE) bar = xcd_barrier_post((unsigned*)(WSB + WS_CTL) + CW_BAR, MISC, wave);
    const int lo = KARG->ph_lo, hi = KARG->ph_hi;
#ifndef PH_MASK
#define PH_MASK 0x1fff
#endif
#ifndef REP_MASK
#define REP_MASK 0x0
#endif
#define REPS(k) for (int rep_ = 0; rep_ < (((REP_MASK) >> (k)) & 1) + 1; rep_ += rep_fence())
#define IN(k) ((((PH_MASK) >> (k)) & 1) && lo <= (k) && (k) < hi)
#define SEAM(k) do { if (IN((k) + 1)) xcd_barrier(bar, wave); } while (0)

    if (IN(0)) { PHASE_LANES();
        REPS(0) {
        ln_rows_f(x_in, ln_emb_g, ln_emb_b, HB, (f32x2*)(WSB + WS_STAT0), gw, NGW, lane);
        LAS float* scr = (LAS float*)(L + wave * 17408);
        { int it = gw;
          if (it < 64 * 128) {
            TItem P = titem_make(w_in, 4096, 8192, WinT, 64 * (it % 64), 64 * (it / 64), 64 * (it / 64), lane); f32x4 v[16]; titem_load(P, v);
            for (;;) {
                const int it2 = it + NGW; const bool more = it2 < 64 * 128; const int itl = more ? it2 : it;
                TItem P2 = titem_make(w_in, 4096, 8192, WinT, 64 * (itl % 64), 64 * (itl / 64), 64 * (itl / 64), lane); f32x4 v2[16]; titem_load(P2, v2);
                titem_finish(P, v, scr, lane);
                if (!more) break;
                P = P2; it = it2;
#pragma unroll
                for (int i = 0; i < 16; ++i) v[i] = v2[i];
            }
          } }
        for (int i = gt; i < 512 * 256; i += NGT) { const int r = i >> 8, c = i & 255; float s, cs; sincos2pi((double)(((r & 255) * c) & 255) * (1.0 / 256.0), s, cs);
            DFT256[i] = (bf16)f2bf(r < 256 ? cs : -s); }
        for (int i = gt; i < 256 * 512; i += NGT) { const int cp = i >> 9, kap = i & 511; float s, cs; sincos2pi((double)(((kap & 255) * cp) & 255) * (1.0 / 256.0), s, cs);
            DFTC[i] = (bf16)f2bf(kap < 256 ? cs : s); }
        for (int i = gt; i < 8192; i += NGT) { float s, cs; sincos2pi((double)i * (1.0 / 8192.0), s, cs); TW[i] = (f32x2){cs, s}; }
        for (int i = gt; i < 8192 * 16; i += NGT) { const int pos = i >> 4, f = i & 15; const float ang = (float)pos * INV_FREQ[f]; float s, cs; sincos2pi((double)ang * 0.15915494309189533577, s, cs);
            ROPEC[i] = cs; ROPES[i] = s; }
        }
        SEAM(0);
    }
    if (IN(1)) { PHASE_LANES();
        REPS(1) {
        { pg8::Gemm g{HB, WinT, 4096u, 4096u, 4096}; pg8::StaticOrder S; S.init(M, NQKV, G, bx); pg8::EpiBf16Q E{UQKV, (unsigned)NQKV, att::SCALE * 1.4426950408889634f, 8, 16, ROPEC, ROPES};
          pg8::gemm_phase<pg8::EpiBf16Q, pg8::AddrPlain>(L, g, S, E, wave); }
        { pg8::Gemm g{WinT + (size_t)NQKV * 4096, HB, 4096u, 32u * 4096u, 4096}; pg8::StaticOrder S; S.init(FW, M, G, bx); pg8::EpiBf16 E{UFT, (unsigned)M};
          pg8::gemm_phase<pg8::EpiBf16, pg8::AddrF1>(L, g, S, E, wave); }
        }
        SEAM(1);
    }
    if (IN(2)) { PHASE_LANES();
        REPS(14) { pg8::Gemm g{DFT256, UFT, 256u, 16384u, 256}; pg8::StaticOrder S; S.init(512, 131072, G, bx); pg8::EpiBf16 E{TT, 131072u};
          pg8::gemm_phase<pg8::EpiBf16, pg8::AddrF2>(L, g, S, E, wave); }
        SEAM(2);
    }
    if (IN(3)) { PHASE_LANES();
#ifndef NO_ATT
#if ATT_V256
        float lam;
        { const float p1 = lq1[lane] * lk1[lane] + lq1[lane + 64] * lk1[lane + 64], p2 = lq2[lane] * lk2[lane] + lq2[lane + 64] * lk2[lane + 64];
          lam = expf(wave_sum(p1)) - expf(wave_sum(p2)) + LAMBDA_INIT; }
        { LAS float* cst = (LAS float*)(L + att2::CST); if (tid < 256) cst[tid] = subln_g[tid] * (1.0f - LAMBDA_INIT); if (tid == 256) cst[256] = lam; }
        __syncthreads();
        int slot = 0; const int my_slot = (bx * 4) / G;
        REPS(3) for (int Lu = bx; Lu < 512; Lu += G) {
            const int vh = (Lu >> 8) * 8 + (Lu & 7), qb = (Lu & 255) >> 3;
            const int b = vh >> 3, h = vh & 7;
            const bf16* Vh = UQKV + (size_t)(b * SEQ) * NQKV + 4096 + h * 256;
            float* Ob = OP + (size_t)(b * SEQ + qb * 256) * 4096 + h * 512 + 256;
            for (int c = 1; c >= 0; --c, ++slot) {
                if (slot == my_slot) LATE_CONVERT();
                const bf16* Qb = UQKV + (size_t)(b * SEQ + qb * 256) * NQKV + h * 256 + c * 128;
                const bf16* Kh = UQKV + (size_t)(b * SEQ) * NQKV + 2048 + h * 256 + c * 128;
                att2::attn_body(Qb, Kh, Vh, Ob, SEQ, L, wave, c == 0);
            }
        }
        asm volatile("s_waitcnt vmcnt(0)" ::: "memory"); __syncthreads();
        if (slot <= my_slot) LATE_CONVERT();
#else
        REPS(3) for (int Lu = bx; Lu < 2048; Lu += G) {
            const int vh = (Lu >> 8) * 8 + (Lu & 7), qb = (Lu & 255) >> 3;
            const int b = vh >> 5, h = (vh >> 2) & 7, c = (vh >> 1) & 1, j = vh & 1;
            const bf16* Qb = UQKV + (size_t)(b * SEQ + qb * 256) * NQKV + h * 256 + c * 128;
            const bf16* Kh = UQKV + (size_t)(b * SEQ) * NQKV + 2048 + h * 256 + c * 128;
            const bf16* Vh = UQKV + (size_t)(b * SEQ) * NQKV + 4096 + h * 256 + j * 128;
            float* Ob = OP + (size_t)(b * SEQ + qb * 256) * 4096 + h * 512 + c * 256 + j * 128;
            att::attn_dense_body(Qb, Kh, Vh, Ob, SEQ, (char*)lds, wave);
        }
#endif
#endif
#ifndef NO_FFT
        constexpr float FSCALE = 0.00069053396600248786f;
        const int lane_f = lane_id_fresh();
        REPS(13) for (int task = gw; task < 16384; task += NGW) {
            const int cq = task & 3, k2 = (task >> 2) & 255, b = (task >> 10) & 1, g = task >> 11, c = cq * 64 + lane_f;
            const bf16* pre = TT + (size_t)k2 * 131072 + (size_t)((g * 2 + b) * 32) * 256 + c;
            const bf16* pim = pre + (size_t)256 * 131072;
            float xr[32], xi[32];
#pragma unroll
            for (int n1 = 0; n1 < 32; ++n1) { const float a = bf2f(pre[n1 * 256]), bb = bf2f(pim[n1 * 256]); const f32x2 w = TW[n1 * k2];
                xr[n1] = a * w.x + bb * w.y; xi[n1] = bb * w.x - a * w.y; }
#pragma unroll
            for (int hh = 16; hh >= 1; hh >>= 1) {
#pragma unroll
                for (int blk = 0; blk < 32; blk += 2 * hh) {
#pragma unroll
                    for (int jj = 0; jj < hh; ++jj) { const int i0 = blk + jj, i1 = i0 + hh; const float wc = W32C[jj * (16 / hh)], wsn = W32S[jj * (16 / hh)];
                        const float ar = xr[i0], ai = xi[i0], br = xr[i1], bi = xi[i1];
                        xr[i0] = ar + br; xi[i0] = ai + bi; const float dr = ar - br, di = ai - bi;
                        xr[i1] = dr * wc + di * wsn; xi[i1] = di * wc - dr * wsn; }
                }
            }
            bf16* zo = ZT + (size_t)(b * SEQ + k2) * 4096 + g * 512 + c;
#pragma unroll
            for (int p = 0; p < 32; ++p) { const int k1 = ((p & 1) << 4) | ((p & 2) << 2) | (p & 4) | ((p & 8) >> 2) | ((p & 16) >> 4);
                zo[(size_t)k1 * 256 * 4096] = (bf16)f2bf(xr[p] * FSCALE); zo[(size_t)k1 * 256 * 4096 + 256] = (bf16)f2bf(xi[p] * FSCALE); }
        }
#endif
        SEAM(3);
    }
    if (IN(4)) { PHASE_LANES();
        REPS(4) {
        { pg8::Gemm g{ZT, DFTC, 4096u, 512u, 512}; pg8::StaticOrder S; S.init(M, 2048, G, bx); pg8::EpiBf16 E{YF, 2048u};
          pg8::gemm_phase<pg8::EpiBf16, pg8::AddrF4>(L, g, S, E, wave); }
        }
        SEAM(4);
    }
    if (IN(5)) { PHASE_LANES();
        REPS(5) {
        { pg8::Gemm g{ATTN, WaoT, 2048u, 2048u, 2048}; pg8::StaticOrder S; S.init(M, 4096, G, bx); pg8::EpiBf16 E{YA, 4096u};
          pg8::gemm_phase<pg8::EpiBf16, pg8::AddrPlain>(L, g, S, E, wave); }
        { pg8::Gemm g{YF, WfT, 2048u, 2048u, 2048}; pg8::StaticOrder S; S.init(M, 4096, G, bx); pg8::EpiBf16 E{YFO, 4096u};
          pg8::gemm_phase<pg8::EpiBf16, pg8::AddrPlain>(L, g, S, E, wave); }
        }
        SEAM(5);
    }
    if (IN(6)) { PHASE_LANES();
        REPS(6) {
        pg8::Gemm g{HB, WgT, 4096u, 4096u, 4096}; pg8::StaticOrder S; S.init(M, 8192, G, bx); pg8::EpiGateMix E{YA, YFO, b_gate, MIX};
        pg8::gemm_phase<pg8::EpiGateMix, pg8::AddrPlain>(L, g, S, E, wave);
        }
        SEAM(6);
    }
    if (IN(7)) { PHASE_LANES();
        pg8::Gemm g{MIX, WmT, 4096u, 4096u, 4096}; pg8::StaticOrder S; S.init(M, 4096, G, bx); pg8::EpiResLN<false> E{R1H, x_in, (const f32x2*)(WSB + WS_STAT0), ln_emb_g, ln_emb_b, 4096u, ALPHA};
        pg8::gemm_phase<pg8::EpiResLN<false>, pg8::AddrPlain>(L, g, S, E, wave);
        SEAM(7);
    }
    if (IN(8)) { PHASE_LANES();
        ln_rows_h(R1H, ln1_g, ln1_b, nullptr, HB, (f32x2*)(WSB + WS_STAT1), gw, NGW, lane);
        SEAM(8);
    }
    if (IN(9)) { PHASE_LANES();
        REPS(9) {
        pg8::Gemm g{HB, WupT, 4096u, 4096u, 4096}; pg8::StaticOrder S; S.init(M, DFF2, G, bx); pg8::EpiConv E{ACT, (float*)(WSB + WS_HALO), conv_w, conv_b, (unsigned)(uintptr_t)(L + RING_BYTES)};
        pg8::gemm_phase<pg8::EpiConv, pg8::AddrPlain>(L, g, S, E, wave);
        }
        { constexpr int NU = (M / 256) * (DFF2 / 256); const int rem = NU % G;
          if (rem == 0 || bx >= rem) {
            const int idx = (rem == 0 ? bx : bx - rem) * NWAVES + wave, cnt = (rem == 0 ? G : G - rem) * NWAVES;
            __syncthreads(); const int lane_c = lane_id_fresh(); LAS float* scr = (LAS float*)(L + wave * 17408);
            int it = idx;
            if (it < 172 * 64) {
                TItem P = titem_make(w_down, DFF, 4096, WdT, 64 * (it % 172), 64 * (it / 172), 64 * (it / 172), lane_c); f32x4 v[16]; titem_load(P, v);
                for (;;) {
                    const int it2 = it + cnt; const bool more = it2 < 172 * 64; const int itl = more ? it2 : it;
                    TItem P2 = titem_make(w_down, DFF, 4096, WdT, 64 * (itl % 172), 64 * (itl / 172), 64 * (itl / 172), lane_c); f32x4 v2[16]; titem_load(P2, v2);
                    titem_finish(P, v, scr, lane_c);
                    if (!more) break;
                    P = P2; it = it2;
#pragma unroll
                    for (int i = 0; i < 16; ++i) v[i] = v2[i];
                }
            }
            asm volatile("s_waitcnt vmcnt(0)" ::: "memory");
          } }
        SEAM(9);
    }
    if (IN(10)) { PHASE_LANES();
        constexpr int NCC = DFF / 4;
        const float* HL = (const float*)(WSB + WS_HALO);
        for (int t = gt; t < 62 * NCC; t += NGT) {
            const int cc = t % NCC, bd = t / NCC, j0 = cc * 4, pmA = (bd / 31) * 32 + (bd % 31), pmB = pmA + 1;
            const f32x4 wg0 = *(const f32x4*)(conv_w + j0), wg1 = *(const f32x4*)(conv_w + DFF2 + j0), wg2 = *(const f32x4*)(conv_w + 2 * DFF2 + j0), bg = *(const f32x4*)(conv_b + j0);
            const f32x4 wv0 = *(const f32x4*)(conv_w + DFF + j0), wv1 = *(const f32x4*)(conv_w + DFF2 + DFF + j0), wv2 = *(const f32x4*)(conv_w + 2 * DFF2 + DFF + j0), bv = *(const f32x4*)(conv_b + DFF + j0);
            const float* hA = HL + (size_t)pmA * 4 * DFF2 + j0; const float* hB = HL + (size_t)pmB * 4 * DFF2 + j0;
            const f32x4 g254 = *(const f32x4*)(hA + 2 * DFF2), g255 = *(const f32x4*)(hA + 3 * DFF2), g0 = *(const f32x4*)(hB), g1 = *(const f32x4*)(hB + DFF2);
            const f32x4 v254 = *(const f32x4*)(hA + 2 * DFF2 + DFF), v255 = *(const f32x4*)(hA + 3 * DFF2 + DFF), v0 = *(const f32x4*)(hB + DFF), v1 = *(const f32x4*)(hB + DFF2 + DFF);
            { const f32x4 cg = g254 * wg0 + g255 * wg1 + g0 * wg2 + bg, cv = v254 * wv0 + v255 * wv1 + v0 * wv2 + bv;
              v2u w; w.x = pk2(cg.x * fast_sigmoid(cg.x) * cv.x, cg.y * fast_sigmoid(cg.y) * cv.y); w.y = pk2(cg.z * fast_sigmoid(cg.z) * cv.z, cg.w * fast_sigmoid(cg.w) * cv.w);
              *(v2u*)(ACT + (size_t)(pmA * 256 + 255) * DFF + j0) = w; }
            { const f32x4 cg = g255 * wg0 + g0 * wg1 + g1 * wg2 + bg, cv = v255 * wv0 + v0 * wv1 + v1 * wv2 + bv;
              v2u w; w.x = pk2(cg.x * fast_sigmoid(cg.x) * cv.x, cg.y * fast_sigmoid(cg.y) * cv.y); w.y = pk2(cg.z * fast_sigmoid(cg.z) * cv.z, cg.w * fast_sigmoid(cg.w) * cv.w);
              *(v2u*)(ACT + (size_t)(pmB * 256) * DFF + j0) = w; }
        }
        SEAM(10);
    }
    if (IN(11)) { PHASE_LANES();
        pg8::Gemm g{ACT, WdT, (unsigned)DFF, (unsigned)DFF, DFF}; pg8::StaticOrder S; S.init(M, 4096, G, bx); pg8::EpiResLN<true> E{R2H, R1H, (const f32x2*)(WSB + WS_STAT1), ln1_g, ln1_b, 4096u, ALPHA};
        pg8::gemm_phase<pg8::EpiResLN<true>, pg8::AddrPlain>(L, g, S, E, wave);
        SEAM(11);
    }
    if (IN(12)) { PHASE_LANES();
        ln_rows_h(R2H, ln2_g, ln2_b, OUT, nullptr, nullptr, gw, NGW, lane);
    }
#undef IN
#undef SEAM
}

extern "C" void kernel_launch(void* const* d_in, const int* in_sizes, int n_in, void* d_out, int out_size, void* d_ws, size_t ws_size, hipStream_t stream) {
    static int grid = 0;
    if (grid == 0) {
        if (n_in != 22 || in_sizes[0] != M * DM || out_size != M * DM || ws_size < WS_END) {
            fprintf(stderr, "kernel_launch: unexpected shapes: n_in %d in0 %d out %d ws %zu (need %zu); nothing launched\n", n_in, n_in > 0 ? in_sizes[0] : -1, out_size, ws_size, (size_t)WS_END); grid = -1; return; }
        int dev = 0, cus = 0, per_cu = 0;
        if (hipGetDevice(&dev) != hipSuccess || hipDeviceGetAttribute(&cus, hipDeviceAttributeMultiprocessorCount, dev) != hipSuccess) { grid = -1; return; }
        if (hipFuncSetAttribute((const void*)fwd, hipFuncAttributeMaxDynamicSharedMemorySize, LDS_BYTES) != hipSuccess) { fprintf(stderr, "kernel_launch: hipFuncSetAttribute failed\n"); grid = -1; return; }
        if (hipOccupancyMaxActiveBlocksPerMultiprocessor(&per_cu, (const void*)fwd, NWAVES * 64, LDS_BYTES) != hipSuccess || per_cu < 1) { fprintf(stderr, "kernel_launch: occupancy query says %d\n", per_cu); }
        (void)hipGetLastError();
        grid = cus;
    }
    if (grid < 0) return;
    if (hipMemsetAsync((char*)d_ws + WS_CTL, 0, CTL_ZERO_BYTES, stream) != hipSuccess) return;
    Args a{};
    for (int i = 0; i < 22; ++i) a.in[i] = (const float*)d_in[i];
    a.out = (float*)d_out; a.ws = (unsigned char*)d_ws;
#if MK_PER_PHASE
    for (int p = 0; p < NPH; ++p) { a.ph_lo = p; a.ph_hi = p + 1; hipLaunchKernelGGL(fwd, dim3(grid), dim3(NWAVES * 64), LDS_BYTES, stream, a); }
#else
    a.ph_lo = 0; a.ph_hi = NPH; hipLaunchKernelGGL(fwd, dim3(grid), dim3(NWAVES * 64), LDS_BYTES, stream, a);
#endif
    const hipError_t le = hipPeekAtLastError();
    if (le != hipSuccess) fprintf(stderr, "kernel_launch: launch failed: %s\n", hipGetErrorName(le));
}
```

```cpp
#include <hip/hip_runtime.h>
#include <cstdio>
#include <cstdint>
#include <cstddef>

#ifndef ATT_V256
#define ATT_V256 1
#endif
#ifndef MK_PER_PHASE
#define MK_PER_PHASE 0
#endif

#define GAS __attribute__((address_space(1)))
#define LAS __attribute__((address_space(3)))
typedef unsigned short bf16;
typedef unsigned v4u __attribute__((ext_vector_type(4)));
typedef unsigned v2u __attribute__((ext_vector_type(2)));
typedef float f32x4 __attribute__((ext_vector_type(4)));
typedef _Float16 h16x4 __attribute__((ext_vector_type(4)));
typedef _Float16 h16x8 __attribute__((ext_vector_type(8)));
typedef float f32x2 __attribute__((ext_vector_type(2)));
typedef short bf16x8 __attribute__((ext_vector_type(8)));
#define LDS_WAIT() asm volatile("s_waitcnt lgkmcnt(0)" ::: "memory")
#define VM_WAIT() asm volatile("s_waitcnt vmcnt(0)" ::: "memory")

constexpr int BATCH = 2, SEQ = 8192, DM = 4096, M = BATCH * SEQ;
constexpr int NQKV = 6144, FW = 2048, DFF = 11008, DFF2 = 22016;
constexpr float ALPHA = 1.189207115002721f, LN_EPS = 1e-5f;
constexpr float LAMBDA_INIT = 0.2f;

constexpr size_t MiB = 1u << 20;
constexpr size_t WS_CTL = 0, CTL_ZERO_BYTES = 64 * 1024;
constexpr size_t TAB_DFT256 = 1 * MiB;
constexpr size_t TAB_DFTC = 1 * MiB + 256 * 1024;
constexpr size_t TAB_TW = 1 * MiB + 512 * 1024;
constexpr size_t TAB_ROPEC = 2 * MiB;
constexpr size_t TAB_ROPES = 2 * MiB + 512 * 1024;
constexpr size_t WS_STAT0 = 3 * MiB;
constexpr size_t WS_STAT1 = 3 * MiB + 128 * 1024;
constexpr size_t W_DT = 4 * MiB;
constexpr size_t W_MT = W_DT + 86 * MiB;
constexpr size_t W_AOT = W_MT + 32 * MiB;
constexpr size_t W_FT = W_AOT + 16 * MiB;
constexpr size_t W_GT = W_FT + 16 * MiB;
constexpr size_t W_INT = W_GT + 64 * MiB;
constexpr size_t W_UPT = W_INT + 64 * MiB;
constexpr size_t WS_ACT = W_UPT + 172 * MiB + 128 * MiB;
constexpr size_t WS_HALO = WS_ACT + 344 * MiB;
constexpr size_t WS_AR = W_UPT + 172 * MiB;
constexpr size_t A_HB = WS_AR;
constexpr size_t A_UQKV = WS_AR + 128 * MiB;
constexpr size_t A_UFT = WS_AR + 320 * MiB;
constexpr size_t A_T = WS_AR + 384 * MiB;
constexpr size_t A_OP = WS_AR + 512 * MiB;
constexpr size_t A_ZT = WS_AR + 768 * MiB;
constexpr size_t A_ATTN = WS_AR + 320 * MiB;
constexpr size_t A_YF = WS_AR + 192 * MiB;
constexpr size_t A_YA = WS_AR + 512 * MiB;
constexpr size_t A_YFO = WS_AR + 640 * MiB;
constexpr size_t A_R1H = WS_AR + 512 * MiB;
constexpr size_t A_R2H = WS_AR + 640 * MiB;
constexpr size_t A_MIX = WS_AR + 384 * MiB;
constexpr size_t A_A = WS_AR + 128 * MiB;
constexpr size_t WS_END = WS_AR + 896 * MiB;
static_assert(WS_HALO + (size_t)64 * 4 * DFF2 * 4 <= WS_END, "act + halo fit in the arena");
static_assert(A_A + (size_t)M * DFF2 * 2 <= WS_END, "a fits");
constexpr int CW_BAR = 1024;

__device__ __forceinline__ unsigned f2bf(float f) { unsigned u = __builtin_bit_cast(unsigned, f); return (u + 0x7fffu + ((u >> 16) & 1u)) >> 16; }
__device__ __forceinline__ unsigned pk2(float lo, float hi) { unsigned r; asm("v_cvt_pk_bf16_f32 %0, %1, %2" : "=v"(r) : "v"(lo), "v"(hi)); return r; }
__device__ __forceinline__ float bf2f(unsigned short b) { return __builtin_bit_cast(float, ((unsigned)b) << 16); }
__device__ __forceinline__ float bflo(unsigned w) { return __builtin_bit_cast(float, w << 16); }
__device__ __forceinline__ float bfhi(unsigned w) { return __builtin_bit_cast(float, w & 0xffff0000u); }
__device__ __forceinline__ unsigned cvt_pk_bf16(float lo, float hi) { unsigned r; asm volatile("v_cvt_pk_bf16_f32 %0, %1, %2" : "=v"(r) : "v"(lo), "v"(hi)); return r; }
__device__ __forceinline__ float wave_sum(float v) {
#pragma unroll
    for (int o = 1; o < 64; o <<= 1) v += __shfl_xor(v, o);
    return v;
}
__device__ __forceinline__ int lane_id_fresh() { int l; asm volatile("v_mbcnt_lo_u32_b32 %0, -1, 0\n\tv_mbcnt_hi_u32_b32 %0, -1, %0" : "=v"(l)); return l; }
__device__ __forceinline__ float fast_sigmoid(float x) { return __builtin_amdgcn_rcpf(1.0f + __builtin_amdgcn_exp2f(-1.4426950408889634f * x)); }
__device__ __forceinline__ void sincos2pi(double x, float& s, float& c) {
    x -= floor(x);
    const int q = (int)(x * 4.0 + 0.5);
    const double r = (x - (double)q * 0.25) * 6.283185307179586476925;
    const double r2 = r * r;
    const double sn = r * (1.0 + r2 * (-1.0 / 6 + r2 * (1.0 / 120 + r2 * (-1.0 / 5040 + r2 * (1.0 / 362880 + r2 * (-1.0 / 39916800 + r2 * (1.0 / 6227020800.0)))))));
    const double cs = 1.0 + r2 * (-0.5 + r2 * (1.0 / 24 + r2 * (-1.0 / 720 + r2 * (1.0 / 40320 + r2 * (-1.0 / 3628800 + r2 * (1.0 / 479001600 + r2 * (-1.0 / 87178291200.0)))))));
    const int qq = q & 3;
    const double S = qq == 0 ? sn : qq == 1 ? cs : qq == 2 ? -sn : -cs;
    const double C = qq == 0 ? cs : qq == 1 ? -sn : qq == 2 ? -cs : sn;
    s = (float)S; c = (float)C;
}

#define XB_TMO      128
#define XB_XCNT(j)  (256  + 64 * (j))
#define XB_XSUB(j)  (1280 + 64 * (j))
#define XB_XGEN(j)  (2304 + 64 * (j))
#define XB_TOP      3328
#define XB_TOPGEN   3392
#define XCD_BAR_WORDS 3456
#define XB_SPIN_CAP (1u << 18)
__device__ __forceinline__ unsigned xb_ld(unsigned* p)              { return __hip_atomic_load(p, __ATOMIC_RELAXED, __HIP_MEMORY_SCOPE_AGENT); }
__device__ __forceinline__ unsigned xb_add(unsigned* p, unsigned v) { return __hip_atomic_fetch_add(p, v, __ATOMIC_RELAXED, __HIP_MEMORY_SCOPE_AGENT); }
__device__ __forceinline__ unsigned xb_xcc_id() { return (unsigned)__builtin_amdgcn_s_getreg((3 << 11) | 20) & 0xFu; }
#define XB_SPIN(cond, bar) do { unsigned _sp = 0; while (cond) { __builtin_amdgcn_s_sleep(1); \
    if ((++_sp & 255u) == 0u) { if (xb_ld(&(bar)[XB_TMO])) break; if (_sp > XB_SPIN_CAP) { atomicAdd(&(bar)[XB_TMO], 1u); break; } } } } while (0)
struct XcdBarrier { unsigned* bar; unsigned x; volatile LAS unsigned* st; };
__device__ __forceinline__ XcdBarrier xcd_barrier_post(unsigned* bar, volatile LAS unsigned* st, int wave) {
    XcdBarrier b; b.bar = bar; b.x = xb_xcc_id(); b.st = st;
    if (wave == 0 && lane_id_fresh() == 0) (void)xb_add(&bar[XB_XCNT(b.x)], 1u);
    return b;
}
__device__ __forceinline__ void xcd_barrier_complete(unsigned* bar, unsigned x, unsigned& nloc, unsigned& nx) {
    const unsigned G = gridDim.x * gridDim.y * gridDim.z;
    unsigned sum, cnt, mine, sp = 0u;
    for (;;) {
        sum = 0u; cnt = 0u; mine = 0u;
#pragma unroll
        for (unsigned j = 0; j < 16; ++j) { const unsigned c = xb_ld(&bar[XB_XCNT(j)]); sum += c; cnt += (c > 0u) ? 1u : 0u; mine = (j == x) ? c : mine; }
        if (sum == G) break;
        __builtin_amdgcn_s_sleep(1);
        if ((++sp & 255u) == 0u) { if (xb_ld(&bar[XB_TMO])) break; if (sp > XB_SPIN_CAP) { atomicAdd(&bar[XB_TMO], 1u); break; } }
    }
    nloc = mine > 0u ? mine : 1u; nx = cnt > 0u ? cnt : 1u;
}
__device__ __forceinline__ void xcd_barrier(const XcdBarrier& b, int wave) {
    asm volatile("s_waitcnt vmcnt(0)" ::: "memory");
    __syncthreads();
    if (wave == 0 && lane_id_fresh() == 0) {
        unsigned* bar = b.bar;
        __builtin_amdgcn_s_waitcnt(0);
        unsigned nloc = b.st[0], nx = b.st[1];
        if (nloc == 0u) { xcd_barrier_complete(bar, b.x, nloc, nx); b.st[0] = nloc; b.st[1] = nx; }
        const unsigned old = xb_add(&bar[XB_XSUB(b.x)], 1u);
        const unsigned gen = old / nloc;
        if (old + 1u == (gen + 1u) * nloc) {
            __builtin_amdgcn_fence(__ATOMIC_RELEASE, "agent");
            asm volatile("s_waitcnt vmcnt(0)" ::: "memory");
            const unsigned og = xb_add(&bar[XB_TOP], 1u);
            const unsigned tg = og / nx;
            if (og + 1u == (tg + 1u) * nx) xb_add(&bar[XB_TOPGEN], 1u);
            else XB_SPIN(xb_ld(&bar[XB_TOPGEN]) == tg, bar);
            __builtin_amdgcn_fence(__ATOMIC_ACQUIRE, "agent");
            xb_add(&bar[XB_XGEN(b.x)], 1u);
            asm volatile("s_waitcnt vmcnt(0)" ::: "memory");
        } else {
            XB_SPIN(xb_ld(&bar[XB_XGEN(b.x)]) == gen, bar);
            __builtin_amdgcn_fence(__ATOMIC_ACQUIRE, "agent");
            asm volatile("s_waitcnt vmcnt(0)" ::: "memory");
        }
    }
    __syncthreads();
}

namespace pg8 {
constexpr int BM = 256, BK = 64, HALF = 128, HTB = HALF * BK * 2, STAGE_BYTES = 8 * HTB, NXCD = 8, WGM = 8;
__host__ __device__ __forceinline__ int lds_byte(int r, int c) { const int st = (r >> 4) * 2 + (c >> 5), rr = r & 15, cc = c & 31, ob = rr * 64 + cc * 2; return st * 1024 + (ob ^ (((ob >> 9) & 1) << 5)); }
__host__ __device__ __forceinline__ void stage_rc(int b, int& R, int& C) { const int st = b / 1024, sb = b % 1024, swz = sb ^ (((sb >> 9) & 1) << 5); R = (st >> 1) * 16 + swz / 64; C = (st & 1) * 32 + (swz % 64) / 2; }
__host__ __device__ __forceinline__ int perm32(int rho) { const int n = rho >> 4, i = rho & 15; return 8 * (i >> 2) + 4 * n + (i & 3); }
struct Unit { int pm, pn; };
struct Gemm { const bf16* A; const bf16* Bt; unsigned lda, ldb; int K; };
struct StaticOrder {
    int nM, nN, nwg, G, c;
    __device__ void init(int M_, int N_, int G_, int c_) { nM = M_ / BM; nN = N_ / BM; nwg = nM * nN; G = G_; c = c_; }
    __device__ bool next(int i, Unit& u) const {
        const long L = (long)i * G + c; if (L >= nwg) return false;
        int wgid = (int)L; { const int q = nwg / NXCD, r = nwg % NXCD, xcd = wgid % NXCD, off = wgid / NXCD; wgid = (xcd < r ? xcd * (q + 1) : r * (q + 1) + (xcd - r) * q) + off; }
        const int nig = WGM * nN, gid = wgid / nig, fm = gid * WGM, gsz = (nM - fm) < WGM ? (nM - fm) : WGM;
        u.pm = fm + ((wgid % nig) % gsz); u.pn = (wgid % nig) / gsz; return true;
    }
};
struct AddrPlain { static __device__ __forceinline__ size_t offA(const Unit& u, const Gemm& g) { return (size_t)u.pm * 256 * g.lda * 2; }
                   static __device__ __forceinline__ size_t offB(const Unit& u, const Gemm& g) { return (size_t)u.pn * 256 * g.ldb * 2; } };
struct AddrF1 { static __device__ __forceinline__ size_t offA(const Unit& u, const Gemm& g) { return (size_t)u.pm * 256 * g.lda * 2; }
                static __device__ __forceinline__ size_t offB(const Unit& u, const Gemm&) { return ((size_t)(u.pn >> 5) * 8192 + (u.pn & 31)) * 4096 * 2; } };
struct AddrF2 { static __device__ __forceinline__ size_t offA(const Unit& u, const Gemm& g) { return (size_t)u.pm * 256 * g.lda * 2; }
                static __device__ __forceinline__ size_t offB(const Unit& u, const Gemm&) { return ((size_t)(u.pn >> 6) * 256 * 16384 + (size_t)(u.pn & 63) * 256) * 2; } };
struct AddrF4 { static __device__ __forceinline__ size_t offA(const Unit& u, const Gemm& g) { return ((size_t)u.pm * 256 * g.lda + (size_t)u.pn * 512) * 2; }
                static __device__ __forceinline__ size_t offB(const Unit&, const Gemm&) { return 0; } };

struct EpiBf16 {
    static constexpr bool PERM = true, APERM = false;
    bf16* O; unsigned ldc;
    __device__ __forceinline__ void operator()(const f32x4 (&acc)[2][2][4][2], const Unit& u, int wr, int wc, int fr, int fq) const {
        const char* base = (const char*)O + ((size_t)u.pm * BM * ldc + (size_t)u.pn * BM) * 2;
        const unsigned loff = ((unsigned)(wr * 64 + fr) * ldc + (unsigned)(wc * 32 + 8 * fq)) * 2u;
#pragma unroll
        for (int ai = 0; ai < 2; ++ai)
#pragma unroll
            for (int m = 0; m < 4; ++m) { const char* rb = base + (size_t)(ai * HALF + m * 16) * ldc * 2;
#pragma unroll
                for (int bj = 0; bj < 2; ++bj) { const f32x4 v0 = acc[ai][bj][m][0], v1 = acc[ai][bj][m][1];
                    v4u w; w.x = cvt_pk_bf16(v0[0], v0[1]); w.y = cvt_pk_bf16(v0[2], v0[3]); w.z = cvt_pk_bf16(v1[0], v1[1]); w.w = cvt_pk_bf16(v1[2], v1[3]);
                    *(v4u*)(rb + bj * HALF * 2 + loff) = w; } }
    }
};
struct EpiBf16Q {
    static constexpr bool PERM = true, APERM = false;
    bf16* O; unsigned ldc; float qscale; int qtiles; int rtiles; const float* ropec; const float* ropes;
    __device__ __forceinline__ void operator()(const f32x4 (&acc)[2][2][4][2], const Unit& u, int wr, int wc, int fr, int fq) const {
        const char* base = (const char*)O + ((size_t)u.pm * BM * ldc + (size_t)u.pn * BM) * 2;
        const unsigned loff = ((unsigned)(wr * 64 + fr) * ldc + (unsigned)(wc * 32 + 8 * fq)) * 2u;
        const float sc = (u.pn < qtiles) ? qscale : 1.0f;
        const bool rot = (u.pn < rtiles) && (wc == 0);
        const float sgn = fq < 2 ? -1.0f : 1.0f; const int fi = 8 * (fq & 1);
#pragma unroll
        for (int ai = 0; ai < 2; ++ai)
#pragma unroll
            for (int m = 0; m < 4; ++m) { const char* rb = base + (size_t)(ai * HALF + m * 16) * ldc * 2;
                f32x4 c0 = {1.f, 1.f, 1.f, 1.f}, c1 = c0, s0 = {0.f, 0.f, 0.f, 0.f}, s1 = s0;
                if (rot) { const int pos = (u.pm * BM + ai * HALF + wr * 64 + m * 16 + fr) & (SEQ - 1);
                    c0 = *(const f32x4*)(ropec + pos * 16 + fi); c1 = *(const f32x4*)(ropec + pos * 16 + fi + 4); s0 = *(const f32x4*)(ropes + pos * 16 + fi) * sgn; s1 = *(const f32x4*)(ropes + pos * 16 + fi + 4) * sgn; }
#pragma unroll
                for (int bj = 0; bj < 2; ++bj) { f32x4 v0 = acc[ai][bj][m][0], v1 = acc[ai][bj][m][1];
                    if (rot) { f32x4 p0, p1;
#pragma unroll
                        for (int e = 0; e < 4; ++e) { p0[e] = __shfl_xor(v0[e], 32); p1[e] = __shfl_xor(v1[e], 32); }
                        v0 = v0 * c0 + p0 * s0; v1 = v1 * c1 + p1 * s1; }
                    v0 *= sc; v1 *= sc;
                    v4u w; w.x = cvt_pk_bf16(v0[0], v0[1]); w.y = cvt_pk_bf16(v0[2], v0[3]); w.z = cvt_pk_bf16(v1[0], v1[1]); w.w = cvt_pk_bf16(v1[2], v1[3]);
                    *(v4u*)(rb + bj * HALF * 2 + loff) = w; } }
    }
};
struct EpiRes {
    static constexpr bool PERM = false, APERM = false;
    float* out; unsigned ldc; float alpha;
    __device__ __forceinline__ void operator()(const f32x4 (&acc)[2][2][4][2], const Unit& u, int wr, int wc, int fr, int fq) const {
        char* base = (char*)out + ((size_t)u.pm * BM * ldc + (size_t)u.pn * BM) * 4;
        const unsigned loff = ((unsigned)(wr * 64 + fr) * ldc + (unsigned)(wc * 32 + 4 * fq)) * 4u;
#pragma unroll
        for (int ai = 0; ai < 2; ++ai)
#pragma unroll
            for (int m = 0; m < 4; ++m) { char* rb = base + (size_t)(ai * HALF + m * 16) * ldc * 4;
#pragma unroll
                for (int bj = 0; bj < 2; ++bj)
#pragma unroll
                    for (int n = 0; n < 2; ++n) { f32x4* p = (f32x4*)(rb + (bj * HALF + n * 16) * 4 + loff); const f32x4 b = *p; *p = b * alpha + acc[ai][bj][m][n]; } }
    }
};
template <bool SRC16> struct EpiResLN {
    static constexpr bool PERM = false, APERM = false;
    _Float16* out; const void* src; const f32x2* stat; const float* gam; const float* bet; unsigned ldc; float alpha;
    __device__ __forceinline__ void operator()(const f32x4 (&acc)[2][2][4][2], const Unit& u, int wr, int wc, int fr, int fq) const {
        constexpr int SB = SRC16 ? 2 : 4;
        const size_t te = (size_t)u.pm * BM * ldc + (size_t)u.pn * BM;
        char* ob = (char*)out + te * 2; const char* sb = (const char*)src + te * SB;
        unsigned leo = (unsigned)(wr * 64 + fr) * ldc + (unsigned)(wc * 32 + 4 * fq);
        asm volatile("" : "+v"(leo));
        const unsigned coff = (unsigned)(u.pn * BM + wc * 32 + 4 * fq) * 4u;
        f32x4 g4[2][2], b4[2][2];
#pragma unroll
        for (int bj = 0; bj < 2; ++bj)
#pragma unroll
            for (int n = 0; n < 2; ++n) { g4[bj][n] = *(const f32x4*)((const char*)gam + coff + (bj * HALF + n * 16) * 4) * alpha; b4[bj][n] = *(const f32x4*)((const char*)bet + coff + (bj * HALF + n * 16) * 4) * alpha; }
        const f32x2* sp = stat + (size_t)u.pm * BM + wr * 64 + fr;
#pragma unroll
        for (int ai = 0; ai < 2; ++ai)
#pragma unroll
            for (int m = 0; m < 4; ++m) { const unsigned re = (unsigned)(ai * HALF + m * 16) * ldc + leo; const f32x2 st = sp[ai * HALF + m * 16];
#pragma unroll
                for (int bj = 0; bj < 2; ++bj)
#pragma unroll
                    for (int n = 0; n < 2; ++n) { const unsigned ce = bj * HALF + n * 16;
                        f32x4 v; if constexpr (SRC16) v = __builtin_convertvector(*(const h16x4*)(sb + (size_t)((re + ce) * 2u)), f32x4); else v = *(const f32x4*)(sb + (size_t)((re + ce) * 4u));
                        *(h16x4*)(ob + (size_t)((re + ce) * 2u)) = __builtin_convertvector((v - st.x) * st.y * g4[bj][n] + b4[bj][n] + acc[ai][bj][m][n], h16x4); }
                asm volatile("" ::: "memory"); }
    }
};
template <int CTRL> __device__ __forceinline__ float dpp_mov(float old, float src) {
    return __builtin_bit_cast(float, __builtin_amdgcn_update_dpp(__builtin_bit_cast(int, old), __builtin_bit_cast(int, src), CTRL, 0xf, 0xf, false)); }
struct EpiConv {
    static constexpr bool PERM = true, APERM = true;
    bf16* act; float* halo; const float* cw; const float* cb; unsigned ldsx;
    __device__ __forceinline__ void operator()(const f32x4 (&acc)[2][2][4][2], const Unit& u, int wr, int wc, int fr, int fq) const {
        LAS float* XL = (LAS float*)(uintptr_t)ldsx;
        const int cbase = wc * 32 + 8 * fq;
        if (fr == 0 || fr == 15) { const int which = fr == 0 ? 0 : 1;
#pragma unroll
            for (int ai = 0; ai < 2; ++ai)
#pragma unroll
                for (int bj = 0; bj < 2; ++bj)
#pragma unroll
                    for (int n = 0; n < 2; ++n) *(LAS f32x4*)(XL + ((((2 * ai + wr) * 2 + which) * 2 + bj) * 128 + cbase + 4 * n)) = fr == 0 ? acc[ai][bj][0][n] : acc[ai][bj][3][n]; }
        if ((wr == 0 && fr == 0) || (wr == 1 && fr == 15)) { float* hp = halo + ((size_t)u.pm * 4 + (wr == 0 ? 0 : 2)) * 22016 + u.pn * 128 + cbase;
#pragma unroll
            for (int bj = 0; bj < 2; ++bj)
#pragma unroll
                for (int n = 0; n < 2; ++n) { *(f32x4*)(hp + bj * 11008 + 4 * n) = wr == 0 ? acc[0][bj][0][n] : acc[1][bj][2][n]; *(f32x4*)(hp + 22016 + bj * 11008 + 4 * n) = wr == 0 ? acc[0][bj][1][n] : acc[1][bj][3][n]; } }
        asm volatile("s_waitcnt lgkmcnt(0)" ::: "memory"); __builtin_amdgcn_s_barrier(); asm volatile("" ::: "memory");
        const unsigned jc = (unsigned)(u.pn * 128 + cbase);
        char* ab = (char*)act + ((size_t)u.pm * BM * 11008 + jc) * 2; const unsigned aoffl = (unsigned)(wr * 64 + 4 * fr) * 11008u * 2u;
        unsigned lo[2][4][2];
#pragma unroll
        for (int n = 0; n < 2; ++n) {
            const f32x4 wg0 = *(const f32x4*)(cw + jc + 4 * n), wg1 = *(const f32x4*)(cw + 22016 + jc + 4 * n), wg2 = *(const f32x4*)(cw + 2 * 22016 + jc + 4 * n), bg = *(const f32x4*)(cb + jc + 4 * n);
            const f32x4 wv0 = *(const f32x4*)(cw + 11008 + jc + 4 * n), wv1 = *(const f32x4*)(cw + 22016 + 11008 + jc + 4 * n), wv2 = *(const f32x4*)(cw + 2 * 22016 + 11008 + jc + 4 * n), bv = *(const f32x4*)(cb + 11008 + jc + 4 * n);
#pragma unroll
            for (int ai = 0; ai < 2; ++ai) { const int b = 2 * ai + wr;
                const f32x4 z4 = {0.f, 0.f, 0.f, 0.f};
                const f32x4 pG = b > 0 ? *(const LAS f32x4*)(XL + ((((b - 1) * 2 + 1) * 2 + 0) * 128 + cbase + 4 * n)) : z4, pV = b > 0 ? *(const LAS f32x4*)(XL + ((((b - 1) * 2 + 1) * 2 + 1) * 128 + cbase + 4 * n)) : z4;
                const f32x4 nG = b < 3 ? *(const LAS f32x4*)(XL + ((((b + 1) * 2 + 0) * 2 + 0) * 128 + cbase + 4 * n)) : z4, nV = b < 3 ? *(const LAS f32x4*)(XL + ((((b + 1) * 2 + 0) * 2 + 1) * 128 + cbase + 4 * n)) : z4;
                f32x4 gprev, vprev, gnext, vnext;
#pragma unroll
                for (int e = 0; e < 4; ++e) {
                    gprev[e] = dpp_mov<0x111>(pG[e], acc[ai][0][3][n][e]); vprev[e] = dpp_mov<0x111>(pV[e], acc[ai][1][3][n][e]);
                    gnext[e] = dpp_mov<0x101>(nG[e], acc[ai][0][0][n][e]); vnext[e] = dpp_mov<0x101>(nV[e], acc[ai][1][0][n][e]); }
#pragma unroll
                for (int m = 0; m < 4; ++m) {
                    const f32x4 gp = m > 0 ? acc[ai][0][m - 1][n] : gprev, vp = m > 0 ? acc[ai][1][m - 1][n] : vprev;
                    const f32x4 gn = m < 3 ? acc[ai][0][m + 1][n] : gnext, vn = m < 3 ? acc[ai][1][m + 1][n] : vnext;
                    const f32x4 cg = wg0 * gp + wg1 * acc[ai][0][m][n] + wg2 * gn + bg, cv = wv0 * vp + wv1 * acc[ai][1][m][n] + wv2 * vn + bv;
                    const unsigned p0 = cvt_pk_bf16(cg[0] * fast_sigmoid(cg[0]) * cv[0], cg[1] * fast_sigmoid(cg[1]) * cv[1]), p1 = cvt_pk_bf16(cg[2] * fast_sigmoid(cg[2]) * cv[2], cg[3] * fast_sigmoid(cg[3]) * cv[3]);
                    if (n == 0) { lo[ai][m][0] = p0; lo[ai][m][1] = p1; }
                    else { v4u w; w.x = lo[ai][m][0]; w.y = lo[ai][m][1]; w.z = p0; w.w = p1; *(v4u*)(ab + (size_t)(ai * HALF + m) * 11008 * 2 + aoffl) = w; } } } }
    }
};
struct EpiGateMix {
    static constexpr bool PERM = true, APERM = false;
    const bf16* ya; const bf16* yf; const float* bgate; bf16* mixed;
    __device__ __forceinline__ void operator()(const f32x4 (&acc)[2][2][4][2], const Unit& u, int wr, int wc, int fr, int fq) const {
        const size_t tb = ((size_t)u.pm * BM * 4096 + (size_t)u.pn * HALF) * 2;
        const char* yab = (const char*)ya + tb; const char* yfb = (const char*)yf + tb; char* mxb = (char*)mixed + tb;
        const unsigned loff = ((unsigned)(wr * 64 + fr) * 4096u + (unsigned)(wc * 32 + 8 * fq)) * 2u;
        const float* bgp = bgate + u.pn * HALF; const unsigned boff = (unsigned)(wc * 32 + 8 * fq) * 4u;
        const f32x4 ba0 = *(const f32x4*)((const char*)bgp + boff), ba1 = *(const f32x4*)((const char*)bgp + boff + 16), bf0 = *(const f32x4*)((const char*)bgp + 16384 + boff), bf1 = *(const f32x4*)((const char*)bgp + 16384 + boff + 16);
#pragma unroll
        for (int ai = 0; ai < 2; ++ai)
#pragma unroll
            for (int m = 0; m < 4; ++m) { const size_t ro = (size_t)(ai * HALF + m * 16) * 4096 * 2;
                const v4u a = *(const v4u*)(yab + ro + loff), f = *(const v4u*)(yfb + ro + loff);
                const f32x4 ga0 = acc[ai][0][m][0] + ba0, ga1 = acc[ai][0][m][1] + ba1, gf0 = acc[ai][1][m][0] + bf0, gf1 = acc[ai][1][m][1] + bf1;
                float r[8];
                r[0] = fast_sigmoid(ga0[0]) * bflo(a.x) + fast_sigmoid(gf0[0]) * bflo(f.x); r[1] = fast_sigmoid(ga0[1]) * bfhi(a.x) + fast_sigmoid(gf0[1]) * bfhi(f.x);
                r[2] = fast_sigmoid(ga0[2]) * bflo(a.y) + fast_sigmoid(gf0[2]) * bflo(f.y); r[3] = fast_sigmoid(ga0[3]) * bfhi(a.y) + fast_sigmoid(gf0[3]) * bfhi(f.y);
                r[4] = fast_sigmoid(ga1[0]) * bflo(a.z) + fast_sigmoid(gf1[0]) * bflo(f.z); r[5] = fast_sigmoid(ga1[1]) * bfhi(a.z) + fast_sigmoid(gf1[1]) * bfhi(f.z);
                r[6] = fast_sigmoid(ga1[2]) * bflo(a.w) + fast_sigmoid(gf1[2]) * bflo(f.w); r[7] = fast_sigmoid(ga1[3]) * bfhi(a.w) + fast_sigmoid(gf1[3]) * bfhi(f.w);
                v4u w; w.x = cvt_pk_bf16(r[0], r[1]); w.y = cvt_pk_bf16(r[2], r[3]); w.z = cvt_pk_bf16(r[4], r[5]); w.w = cvt_pk_bf16(r[6], r[7]);
                *(v4u*)(mxb + ro + loff) = w; }
    }
};

template <class Epi, class Addr, bool ALIGN_EPI = true>
__device__ __forceinline__ void gemm_phase(LAS unsigned char* lds, const Gemm g, const StaticOrder& S, const Epi& E, const int wid) {
    const int lane = lane_id_fresh(), tid = wid * 64 + lane,
              wr = wid >> 2, wc = wid & 3, fr = lane & 15, fq = lane >> 4;
    const int K = g.K, nt = K / BK;
    unsigned voffA[2], voffB[2];
#pragma unroll
    for (int i = 0; i < 2; ++i) { int R, C; stage_rc(tid * 16 + i * 8192, R, C); const int Rb = Epi::PERM ? ((R & ~31) + perm32(R & 31)) : R;
        const int Ra = Epi::APERM ? ((R & 64) + 4 * (R & 15) + ((R >> 4) & 3)) : R;
        voffA[i] = ((unsigned)Ra * g.lda + (unsigned)C) * 2u; voffB[i] = ((unsigned)Rb * g.ldb + (unsigned)C) * 2u; }
    const size_t kstep = (size_t)(BK * 2);
    const size_t hstepA = (size_t)HALF * g.lda * 2, hstepB = (size_t)HALF * g.ldb * 2;
    const unsigned ldsw = (unsigned)wid * 1024u, ldsbase = (unsigned)(uintptr_t)lds;
    const int aoff = lds_byte(wr * 64 + fr, fq * 8), boff = lds_byte(wc * 32 + fr, fq * 8);
#define PG8_SA(b, h) (((b) * 2 + (h)) * HTB)
#define PG8_SB(b, h) ((4 + (b) * 2 + (h)) * HTB)
#define PG8_STAGE(bufoff, gbase, voff) do { const unsigned la0_ = ldsbase + (unsigned)(bufoff) + ldsw, la1_ = la0_ + 8192u; const char* gb_ = (const char*)(gbase); unsigned keep_; \
        asm volatile("s_mov_b32 %0, m0\n\ts_mov_b32 m0, %4\n\ts_nop 0\n\tglobal_load_lds_dwordx4 %1, %3\n\ts_mov_b32 m0, %5\n\ts_nop 0\n\tglobal_load_lds_dwordx4 %2, %3\n\ts_mov_b32 m0, %0" \
                     : "=&s"(keep_) : "v"((voff)[0]), "v"((voff)[1]), "s"(gb_), "s"(la0_), "s"(la1_) : "memory"); } while (0)
#define PG8_LDA(dst, b, h) do { _Pragma("unroll") for (int m = 0; m < 4; ++m) _Pragma("unroll") for (int k = 0; k < 2; ++k) dst[m][k] = *(const LAS bf16x8*)(lds + PG8_SA(b, h) + aoff + m * 2048 + k * 1024); } while (0)
#define PG8_LDB(dst, b, h) do { _Pragma("unroll") for (int n = 0; n < 2; ++n) _Pragma("unroll") for (int k = 0; k < 2; ++k) dst[n][k] = *(const LAS bf16x8*)(lds + PG8_SB(b, h) + boff + n * 2048 + k * 1024); } while (0)
#define PG8_MMA(ai, bj, At, Bt) do { __builtin_amdgcn_s_setprio(1); _Pragma("unroll") for (int m = 0; m < 4; ++m) _Pragma("unroll") for (int n = 0; n < 2; ++n) _Pragma("unroll") for (int k = 0; k < 2; ++k) \
        acc[ai][bj][m][n] = __builtin_amdgcn_mfma_f32_16x16x32_bf16(Bt[n][k], At[m][k], acc[ai][bj][m][n], 0, 0, 0); __builtin_amdgcn_s_setprio(0); } while (0)
#define PG8_WAIT_V(n) asm volatile("s_waitcnt vmcnt(" #n ")" ::: "memory")
#define PG8_WAIT_L(n) asm volatile("s_waitcnt lgkmcnt(" #n ")" ::: "memory")
#define PG8_BAR __builtin_amdgcn_s_barrier()
#define PG8_SCHED __builtin_amdgcn_sched_barrier(0)
    Unit cur, nxt; int ui = 0;
    if (!S.next(0, cur)) return;
    f32x4 acc[2][2][4][2];
#pragma unroll
    for (int a = 0; a < 2; ++a)
#pragma unroll
        for (int b = 0; b < 2; ++b)
#pragma unroll
            for (int m = 0; m < 4; ++m)
#pragma unroll
                for (int n = 0; n < 2; ++n) acc[a][b][m][n] = (f32x4){0.f, 0.f, 0.f, 0.f};
    bf16x8 At[4][2], B0[2][2], B1[2][2];
    const char* cA = (const char*)g.A + Addr::offA(cur, g); const char* cB = (const char*)g.Bt + Addr::offB(cur, g);
    PG8_STAGE(PG8_SB(0, 0), cB, voffB); PG8_STAGE(PG8_SB(0, 1), cB + hstepB, voffB); PG8_STAGE(PG8_SA(0, 0), cA, voffA); PG8_STAGE(PG8_SA(0, 1), cA + hstepA, voffA);
    if (wr == 1) PG8_BAR;
    PG8_WAIT_V(2); PG8_BAR;
    PG8_STAGE(PG8_SB(1, 0), cB + kstep, voffB); PG8_STAGE(PG8_SA(1, 0), cA + kstep, voffA); PG8_STAGE(PG8_SB(1, 1), cB + hstepB + kstep, voffB);
    PG8_WAIT_V(6); PG8_BAR;
    for (;;) {
        const bool has_next = S.next(ui + 1, nxt);
        const char* nA = has_next ? (const char*)g.A + Addr::offA(nxt, g) : cA; const char* nB = has_next ? (const char*)g.Bt + Addr::offB(nxt, g) : cB;
        for (int t = 0; t < nt; t += 2) {
            const bool last = (t == nt - 2);
            const char* a1 = cA + (size_t)(t + 1) * kstep;
            const char* a2 = last ? nA : cA + (size_t)(t + 2) * kstep; const char* b2 = last ? nB : cB + (size_t)(t + 2) * kstep;
            const char* a3 = a2 + kstep; const char* b3 = b2 + kstep;
            PG8_LDB(B0, 0, 0); PG8_LDB(B1, 0, 1); PG8_SCHED; PG8_LDA(At, 0, 0); PG8_STAGE(PG8_SA(1, 1), a1 + hstepA, voffA);
            PG8_WAIT_V(8); PG8_WAIT_L(0); PG8_BAR; PG8_MMA(0, 0, At, B0); PG8_MMA(0, 1, At, B1); PG8_BAR; PG8_SCHED;
            PG8_LDA(At, 0, 1); PG8_STAGE(PG8_SB(0, 0), b2, voffB); PG8_STAGE(PG8_SB(0, 1), b2 + hstepB, voffB); PG8_STAGE(PG8_SA(0, 0), a2, voffA);
            PG8_WAIT_V(8); PG8_WAIT_L(0); PG8_BAR; PG8_MMA(1, 0, At, B0); PG8_MMA(1, 1, At, B1); PG8_BAR; PG8_SCHED;
            PG8_LDB(B0, 1, 0); PG8_LDB(B1, 1, 1); PG8_SCHED; PG8_LDA(At, 1, 0); PG8_STAGE(PG8_SA(0, 1), a2 + hstepA, voffA);
            PG8_WAIT_V(8); PG8_WAIT_L(0); PG8_BAR; PG8_MMA(0, 0, At, B0); PG8_MMA(0, 1, At, B1); PG8_BAR; PG8_SCHED;
            PG8_LDA(At, 1, 1); PG8_STAGE(PG8_SB(1, 0), b3, voffB); PG8_STAGE(PG8_SB(1, 1), b3 + hstepB, voffB); PG8_STAGE(PG8_SA(1, 0), a3, voffA);
            PG8_WAIT_V(8); PG8_WAIT_L(0); PG8_BAR; PG8_MMA(1, 0, At, B0); PG8_MMA(1, 1, At, B1); PG8_BAR; PG8_SCHED;
        }
        if constexpr (ALIGN_EPI) { if (wr == 0) PG8_BAR; }
        E(acc, cur, wr, wc, fr, fq);
        if (!has_next) break;
#pragma unroll
        for (int a = 0; a < 2; ++a)
#pragma unroll
            for (int b = 0; b < 2; ++b)
#pragma unroll
                for (int m = 0; m < 4; ++m)
#pragma unroll
                    for (int n = 0; n < 2; ++n) acc[a][b][m][n] = (f32x4){0.f, 0.f, 0.f, 0.f};
        cur = nxt; cA = nA; cB = nB; ++ui;
        if constexpr (ALIGN_EPI) { if (wr == 1) PG8_BAR; }
    }
    PG8_WAIT_V(0);
    if constexpr (!ALIGN_EPI) { if (wr == 0) PG8_BAR; }
    PG8_BAR;
#undef PG8_SA
#undef PG8_SB
#undef PG8_STAGE
#undef PG8_LDA
#undef PG8_LDB
#undef PG8_MMA
#undef PG8_WAIT_V
#undef PG8_WAIT_L
#undef PG8_BAR
#undef PG8_SCHED
}
}

namespace att {
constexpr int D = 128, NW = 8, QBLK = 32, KVBLK = 64;
constexpr float SCALE = 0.088388347648318440f;
constexpr float THR = 8.f;
constexpr int LDQ = NQKV, LDK = NQKV, LDO = 4096;
constexpr size_t SHM_V = KVBLK * D * 2, SHM_K = KVBLK * D * 2, SHM_ATTN = 2 * SHM_V + 2 * SHM_K + NW * 64 * 4;
using s16x4 = __attribute__((ext_vector_type(4))) short;
using f32x16 = __attribute__((ext_vector_type(16))) float;
#define KSWZ(row, colB) ((row) * 256 + ((colB) ^ (((row) & 7) << 4)))
#define SBAR() __builtin_amdgcn_sched_barrier(0)
__device__ __forceinline__ int crow(int r, int hi) { return (r & 3) + 8 * (r >> 2) + 4 * hi; }
__device__ __forceinline__ unsigned cvtpk(float lo, float hi) { unsigned r; asm volatile("v_cvt_pk_bf16_f32 %0, %1, %2" : "=v"(r) : "v"(lo), "v"(hi)); return r; }
__device__ __forceinline__ void partialSM(f32x16& p0, f32x16& p1, float& m_reg, float& mn, float& alpha) {
  constexpr float C = SCALE * 1.4426950408889634f;
  float pmax = p0[0];
#pragma unroll
  for (int r = 1; r < 16; ++r) pmax = fmaxf(pmax, p0[r]);
#pragma unroll
  for (int r = 0; r < 16; ++r) pmax = fmaxf(pmax, p1[r]);
  { auto rr = __builtin_amdgcn_permlane32_swap(__float_as_uint(pmax), __float_as_uint(pmax), false, false);
    pmax = fmaxf(__uint_as_float(rr[0]), __uint_as_float(rr[1])); }
  if (__builtin_expect(__all(pmax - m_reg <= THR / SCALE), 1)) { mn = m_reg; alpha = 1.f; }
  else { mn = fmaxf(m_reg, pmax); alpha = __builtin_amdgcn_exp2f((m_reg - mn) * C); m_reg = mn; }
  float mnC = -mn * C;
#pragma unroll
  for (int r = 0; r < 16; ++r) p0[r] = fmaf(p0[r], C, mnC);
#pragma unroll
  for (int r = 0; r < 16; ++r) p1[r] = fmaf(p1[r], C, mnC);
#pragma unroll
  for (int r = 0; r < 16; ++r) p0[r] = __builtin_amdgcn_exp2f(p0[r]);
}
__device__ __forceinline__ void finishSM(f32x16& p0, f32x16& p1, float alpha, float& l_reg, bf16x8& pa0, bf16x8& pa1, bf16x8& pa2, bf16x8& pa3) {
#pragma unroll
  for (int r = 0; r < 16; ++r) p1[r] = __builtin_amdgcn_exp2f(p1[r]);
  float ps = 0;
#pragma unroll
  for (int r = 0; r < 16; ++r) ps += p0[r];
#pragma unroll
  for (int r = 0; r < 16; ++r) ps += p1[r];
  { auto rr = __builtin_amdgcn_permlane32_swap(__float_as_uint(ps), __float_as_uint(ps), false, false);
    ps = __uint_as_float(rr[0]) + __uint_as_float(rr[1]); }
  l_reg = l_reg * alpha + ps;
#define PK4(P, BASE, OUT) do { unsigned a0 = cvtpk(P[BASE + 0], P[BASE + 1]), a1 = cvtpk(P[BASE + 2], P[BASE + 3]);   \
    unsigned b0 = cvtpk(P[BASE + 4], P[BASE + 5]), b1 = cvtpk(P[BASE + 6], P[BASE + 7]);                              \
    auto r0 = __builtin_amdgcn_permlane32_swap(a0, b0, false, false); auto r1 = __builtin_amdgcn_permlane32_swap(a1, b1, false, false); \
    v4u w = {r0[0], r1[0], r0[1], r1[1]}; OUT = *reinterpret_cast<bf16x8*>(&w); } while (0)
  PK4(p0, 0, pa0); PK4(p0, 8, pa1); PK4(p1, 0, pa2); PK4(p1, 8, pa3);
#undef PK4
}
__device__ __forceinline__ void qkt(f32x16& p0, f32x16& p1, const bf16* Ks, const bf16x8* qr, int r32, int hi) {
  p0 = f32x16{}; p1 = f32x16{};
#pragma unroll
  for (int d0 = 0; d0 < 8; ++d0) { int cb = (d0 * 16 + hi * 8) * 2;
    bf16x8 b0 = *reinterpret_cast<const bf16x8*>((const char*)Ks + KSWZ(r32, cb));
    bf16x8 b1 = *reinterpret_cast<const bf16x8*>((const char*)Ks + KSWZ(32 + r32, cb));
    p0 = __builtin_amdgcn_mfma_f32_32x32x16_bf16(b0, qr[d0], p0, 0, 0, 0);
    p1 = __builtin_amdgcn_mfma_f32_32x32x16_bf16(b1, qr[d0], p1, 0, 0, 0); }
}
__device__ __forceinline__ int v_st(int k, int c) { const int kk = (k & ~0xC) | ((k & 4) << 1) | ((k & 8) >> 1); return ((kk >> 3) * 4 + (c >> 5)) * 512 + ((kk & 7) * 32 + (c & 31)) * 2; }
__device__ __forceinline__ int v_rd_base(int lane) { return ((lane & 3) << 3) | (((lane >> 2) & 3) << 6) | (((lane >> 4) & 1) << 5) | (((lane >> 5) & 1) << 8); }
constexpr int v_rd_off(int d0, int ks, int half) { return d0 * 512 + ks * 4096 + half * 2048; }
template <int OFF> __device__ __forceinline__ s16x4 tr_read(int vb) {
  s16x4 r; asm volatile("ds_read_b64_tr_b16 %0, %1 offset:%2" : "=&v"(r) : "v"(vb), "i"(OFF) : "memory"); return r;
}
template <int D0> __device__ __forceinline__ void pv_one(f32x16& od, int vb, bf16x8 pa0, bf16x8 pa1, bf16x8 pa2, bf16x8 pa3) {
  const s16x4 l0 = tr_read<v_rd_off(D0, 0, 0)>(vb), h0 = tr_read<v_rd_off(D0, 0, 1)>(vb), l1 = tr_read<v_rd_off(D0, 1, 0)>(vb), h1 = tr_read<v_rd_off(D0, 1, 1)>(vb);
  const s16x4 l2 = tr_read<v_rd_off(D0, 2, 0)>(vb), h2 = tr_read<v_rd_off(D0, 2, 1)>(vb), l3 = tr_read<v_rd_off(D0, 3, 0)>(vb), h3 = tr_read<v_rd_off(D0, 3, 1)>(vb);
  asm volatile("s_waitcnt lgkmcnt(0)" ::: "memory"); SBAR();
#define PK(L, H) (bf16x8){L[0], L[1], L[2], L[3], H[0], H[1], H[2], H[3]}
  od = __builtin_amdgcn_mfma_f32_32x32x16_bf16(pa0, PK(l0, h0), od, 0, 0, 0);
  od = __builtin_amdgcn_mfma_f32_32x32x16_bf16(pa1, PK(l1, h1), od, 0, 0, 0);
  od = __builtin_amdgcn_mfma_f32_32x32x16_bf16(pa2, PK(l2, h2), od, 0, 0, 0);
  od = __builtin_amdgcn_mfma_f32_32x32x16_bf16(pa3, PK(l3, h3), od, 0, 0, 0);
#undef PK
}
__device__ __forceinline__ void pv_d0(f32x16* o, int vb, bf16x8 pa0, bf16x8 pa1, bf16x8 pa2, bf16x8 pa3) {
  pv_one<0>(o[0], vb, pa0, pa1, pa2, pa3); pv_one<1>(o[1], vb, pa0, pa1, pa2, pa3); pv_one<2>(o[2], vb, pa0, pa1, pa2, pa3); pv_one<3>(o[3], vb, pa0, pa1, pa2, pa3);
}
__device__ __forceinline__ void attn_dense_body(const bf16* __restrict__ Qb, const bf16* __restrict__ Kh, const bf16* __restrict__ Vh, float* __restrict__ Ob, int seq, char* lds, const int wid) {
  const int lane = lane_id_fresh(), tid = wid * 64 + lane, r32 = lane & 31, hi = lane >> 5;
  bf16* V_lds = (bf16*)lds; bf16* K_lds = (bf16*)(lds + 2 * SHM_V);
  float* ws = (float*)(lds + 2 * SHM_V + 2 * SHM_K) + wid * 64; float* li_l = ws; float* al_l = ws + 32;
  float m_reg = -1e30f, l_reg = 0; f32x16 o[4] = {}; bf16x8 qr[8];
  const bf16* Qw = Qb + (long)(wid * QBLK + r32) * LDQ + hi * 8;
#pragma unroll
  for (int d0 = 0; d0 < 8; ++d0) qr[d0] = *reinterpret_cast<const bf16x8*>(Qw + d0 * 16);
  const int sr = tid >> 4, sc = (tid & 15) * 8, vst0 = v_st(sr, sc), vst1 = v_st(32 + sr, sc);
  const int vb0 = (int)(uintptr_t)V_lds + v_rd_base(lane);
  const unsigned goff0 = (unsigned)(sr * LDK + sc) * 2u, goff1 = goff0 + 32u * LDK * 2u;
  struct { bf16x8 vs0, vs1, ks0, ks1; } sr_[2];
#define SLOAD(i, k0) do { const char* kb_ = (const char*)Kh + (size_t)(k0) * (LDK * 2); const char* vb_ = (const char*)Vh + (size_t)(k0) * (LDK * 2); \
    sr_[i].vs0 = *reinterpret_cast<const bf16x8*>(vb_ + goff0); sr_[i].vs1 = *reinterpret_cast<const bf16x8*>(vb_ + goff1); \
    sr_[i].ks0 = *reinterpret_cast<const bf16x8*>(kb_ + goff0); sr_[i].ks1 = *reinterpret_cast<const bf16x8*>(kb_ + goff1); } while (0)
#define SWRITE(b, i) do { *(bf16x8*)((char*)V_lds + (b) * SHM_V + vst0) = sr_[i].vs0;          \
    *(bf16x8*)((char*)V_lds + (b) * SHM_V + vst1) = sr_[i].vs1; int kc = sc * 2;               \
    *(bf16x8*)((char*)K_lds + (b) * SHM_K + KSWZ(sr, kc)) = sr_[i].ks0;                       \
    *(bf16x8*)((char*)K_lds + (b) * SHM_K + KSWZ(32 + sr, kc)) = sr_[i].ks1; } while (0)
#define SWAIT() asm volatile("s_waitcnt vmcnt(4)" ::: "memory")
#define RESC(a) do { if (__any((a) < 1.f)) { if (hi == 0) al_l[r32] = (a); asm volatile("s_waitcnt lgkmcnt(0)" ::: "memory"); \
    _Pragma("unroll") for (int d = 0; d < 4; ++d) _Pragma("unroll") for (int r = 0; r < 16; ++r) o[d][r] *= al_l[crow(r, hi)]; } } while (0)
  f32x16 pA0, pA1, pB0, pB1; float mnA, mnB, alA, alB; bf16x8 pa0, pa1, pa2, pa3; const int NT = seq / KVBLK;
  constexpr int SE = 0, SO = 1;
  SLOAD(SE, 0); asm volatile("s_waitcnt vmcnt(0)" ::: "memory"); SWRITE(0, SE); __syncthreads();
  qkt(pA0, pA1, K_lds, qr, r32, hi); partialSM(pA0, pA1, m_reg, mnA, alA);
  SLOAD(SO, KVBLK); if (2 < NT) SLOAD(SE, 2 * KVBLK);
  SWAIT(); SWRITE(1, SO); __syncthreads();
  for (int j = 1; j + 1 < NT; j += 2) {
    SBAR(); qkt(pB0, pB1, (bf16*)((char*)K_lds + SHM_K), qr, r32, hi);
    finishSM(pA0, pA1, alA, l_reg, pa0, pa1, pa2, pa3); SBAR();
    SLOAD(SO, (j + 2) * KVBLK); SBAR();
    pv_d0(o, vb0, pa0, pa1, pa2, pa3); partialSM(pB0, pB1, m_reg, mnB, alB);
    __syncthreads(); SWAIT(); SWRITE(0, SE);
    RESC(alB); __syncthreads();
    SBAR(); qkt(pA0, pA1, K_lds, qr, r32, hi);
    finishSM(pB0, pB1, alB, l_reg, pa0, pa1, pa2, pa3); SBAR();
    if (j + 3 < NT) SLOAD(SE, (j + 3) * KVBLK); SBAR();
    pv_d0(o, vb0 + (int)SHM_V, pa0, pa1, pa2, pa3); partialSM(pA0, pA1, m_reg, mnA, alA);
    __syncthreads(); SWAIT(); SWRITE(1, SO);
    RESC(alA); __syncthreads();
  }
  SBAR(); qkt(pB0, pB1, (bf16*)((char*)K_lds + SHM_K), qr, r32, hi);
  finishSM(pA0, pA1, alA, l_reg, pa0, pa1, pa2, pa3); SBAR();
  pv_d0(o, vb0, pa0, pa1, pa2, pa3); partialSM(pB0, pB1, m_reg, mnB, alB);
  __syncthreads(); RESC(alB);
  finishSM(pB0, pB1, alB, l_reg, pa0, pa1, pa2, pa3); SBAR();
  pv_d0(o, vb0 + (int)SHM_V, pa0, pa1, pa2, pa3);
  if (hi == 0) li_l[r32] = l_reg; asm volatile("s_waitcnt lgkmcnt(0)" ::: "memory");
  float rli[16];
#pragma unroll
  for (int r = 0; r < 16; ++r) rli[r] = __builtin_amdgcn_rcpf(li_l[crow(r, hi)]);
  float* Ow = Ob + (long)(wid * QBLK) * LDO;
#pragma unroll
  for (int r = 0; r < 16; ++r) { int orow = crow(r, hi);
#pragma unroll
    for (int d0 = 0; d0 < 4; ++d0) Ow[(long)orow * LDO + d0 * 32 + r32] = o[d0][r] * rli[r]; }
  __syncthreads();
#undef SLOAD
#undef SWRITE
#undef SWAIT
#undef RESC
}
}

namespace att2 {
using att::f32x16; using att::s16x4; using att::crow; using att::cvtpk; using att::tr_read; using att::v_rd_base;
constexpr int KVBLK = 64, LDK = NQKV, LDQ = NQKV, LDO = 4096;
constexpr float SCALE = att::SCALE, THR = att::THR;
constexpr int KB0 = 0, VB0 = 49152, SCR = 114688;
constexpr int CST = 139264;
constexpr int LDS_NEED = CST + 2048;
template <int OFF> __device__ __forceinline__ bf16x8 k_read(int va) { bf16x8 r; asm volatile("ds_read_b128 %0, %1 offset:%2" : "=&v"(r) : "v"(va), "i"(OFF) : "memory"); return r; }
template <int D0> __device__ __forceinline__ void pv_one(f32x16& od, int vb, bf16x8 pa0, bf16x8 pa1, bf16x8 pa2, bf16x8 pa3) {
  constexpr int B = (D0 & 3) * 512 + (D0 >> 2) * 16384;
  const s16x4 l0 = tr_read<B + 0>(vb), h0 = tr_read<B + 2048>(vb), l1 = tr_read<B + 4096>(vb), h1 = tr_read<B + 4096 + 2048>(vb);
  const s16x4 l2 = tr_read<B + 8192>(vb), h2 = tr_read<B + 8192 + 2048>(vb), l3 = tr_read<B + 12288>(vb), h3 = tr_read<B + 12288 + 2048>(vb);
  asm volatile("s_waitcnt lgkmcnt(0)" ::: "memory"); SBAR();
#define PK(L, H) (bf16x8){L[0], L[1], L[2], L[3], H[0], H[1], H[2], H[3]}
  od = __builtin_amdgcn_mfma_f32_32x32x16_bf16(pa0, PK(l0, h0), od, 0, 0, 0);
  od = __builtin_amdgcn_mfma_f32_32x32x16_bf16(pa1, PK(l1, h1), od, 0, 0, 0);
  od = __builtin_amdgcn_mfma_f32_32x32x16_bf16(pa2, PK(l2, h2), od, 0, 0, 0);
  od = __builtin_amdgcn_mfma_f32_32x32x16_bf16(pa3, PK(l3, h3), od, 0, 0, 0);
#undef PK
}
__device__ __forceinline__ void attn_body(const bf16* __restrict__ Qb, const bf16* __restrict__ Kh, const bf16* __restrict__ Vh, float* __restrict__ Ob, int seq, LAS unsigned char* lds, const int wid, const bool fin) {
  const int lane = lane_id_fresh(), r32 = lane & 31, hi = lane >> 5;
  LAS float* wsf = (LAS float*)(lds + SCR) + wid * 64; LAS float* li_l = wsf; LAS float* al_l = wsf + 32;
  float m_reg = 0.f, l_reg = 0; f32x16 o[8] = {}; bf16x8 qr[8];
  const bf16* Qw = Qb + (long)(wid * 32 + r32) * LDQ + hi * 8;
#pragma unroll
  for (int d0 = 0; d0 < 8; ++d0) qr[d0] = *reinterpret_cast<const bf16x8*>(Qw + d0 * 16);
  const int grp = wid >> 2, wb = wid & 3;
  unsigned kofs0, kofs1, vofs;
  { const int l4 = lane >> 4; kofs0 = (unsigned)((16 * wb + l4) * LDK * 2 + (((lane & 15) ^ l4) * 16)); kofs1 = (unsigned)((16 * wb + l4) * LDK * 2 + (((lane & 15) ^ (4 + l4)) * 16));
    const int r8 = (lane >> 2) & 7; vofs = (unsigned)((16 * wb + 8 * (r8 >> 2) + (r8 & 3)) * LDK * 2 + (lane >> 5) * 64 + (lane & 3) * 16); }
  const unsigned dsto = (unsigned)wb * 4096u;
  const unsigned ldsk0 = (unsigned)(uintptr_t)(lds + KB0) + dsto, ldsv0 = (unsigned)(uintptr_t)(lds + VB0) + dsto;
#define ISSUE_K(buf, k0) do { const char* kb0_ = (const char*)Kh + (size_t)(k0) * (LDK * 2); const char* kb1_ = kb0_ + 4 * LDK * 2; const char* kb2_ = kb0_ + 8 * LDK * 2; const char* kb3_ = kb0_ + 12 * LDK * 2; \
    const unsigned lk_ = ldsk0 + (unsigned)(buf); unsigned keep_; \
    asm volatile("s_mov_b32 %0, m0\n\t" \
      "s_add_u32 m0, %7, 0\n\ts_nop 0\n\tglobal_load_lds_dwordx4 %1, %3\n\t" \
      "s_add_u32 m0, %7, 1024\n\ts_nop 0\n\tglobal_load_lds_dwordx4 %2, %4\n\t" \
      "s_add_u32 m0, %7, 2048\n\ts_nop 0\n\tglobal_load_lds_dwordx4 %1, %5\n\t" \
      "s_add_u32 m0, %7, 3072\n\ts_nop 0\n\tglobal_load_lds_dwordx4 %2, %6\n\t" \
      "s_mov_b32 m0, %0" : "=&s"(keep_) : "v"(kofs0), "v"(kofs1), "s"(kb0_), "s"(kb1_), "s"(kb2_), "s"(kb3_), "s"(lk_) : "memory", "scc"); } while (0)
#define ISSUE_V(buf, k0) do { const char* vb0_ = (const char*)Vh + (size_t)(k0) * (LDK * 2); const char* vb1_ = vb0_ + 4 * LDK * 2; \
    const unsigned lv_ = ldsv0 + (buf) * 32768u; unsigned keep_; \
    asm volatile("s_mov_b32 %0, m0\n\t" \
      "s_add_u32 m0, %4, 0\n\ts_nop 0\n\tglobal_load_lds_dwordx4 %1, %2\n\t" \
      "s_add_u32 m0, %4, 16128\n\ts_nop 0\n\tglobal_load_lds_dwordx4 %1, %2 offset:256\n\t" \
      "s_add_u32 m0, %4, 896\n\ts_nop 0\n\tglobal_load_lds_dwordx4 %1, %2 offset:128\n\t" \
      "s_add_u32 m0, %4, 17024\n\ts_nop 0\n\tglobal_load_lds_dwordx4 %1, %2 offset:384\n\t" \
      "s_add_u32 m0, %4, 2048\n\ts_nop 0\n\tglobal_load_lds_dwordx4 %1, %3\n\t" \
      "s_add_u32 m0, %4, 18176\n\ts_nop 0\n\tglobal_load_lds_dwordx4 %1, %3 offset:256\n\t" \
      "s_add_u32 m0, %4, 2944\n\ts_nop 0\n\tglobal_load_lds_dwordx4 %1, %3 offset:128\n\t" \
      "s_add_u32 m0, %4, 19072\n\ts_nop 0\n\tglobal_load_lds_dwordx4 %1, %3 offset:384\n\t" \
      "s_mov_b32 m0, %0" : "=&s"(keep_) : "v"(vofs), "s"(vb0_), "s"(vb1_), "s"(lv_) : "memory", "scc"); } while (0)
  const int vbase = (int)(uintptr_t)(lds + VB0) + v_rd_base(lane);
  int kaddr[4];
#pragma unroll
  for (int d0 = 0; d0 < 4; ++d0) kaddr[d0] = (int)(uintptr_t)lds + r32 * 256 + ((d0 * 32 + hi * 16) ^ ((r32 & 7) << 4));
  const int NT = seq / KVBLK;
  constexpr float THR2 = THR * 1.4426950408889634f;
#define KWAIT(n) do { asm volatile("s_waitcnt lgkmcnt(" #n ")" ::: "memory"); SBAR(); } while (0)
#define KLOAD1(kf, buf, d0) do { kf[0] = k_read<((d0) >> 2) * 128>(ka[(d0) & 3]); kf[1] = k_read<8192 + ((d0) >> 2) * 128>(ka[(d0) & 3]); } while (0)
#define KMMA1(kf, d0) do { p0 = __builtin_amdgcn_mfma_f32_32x32x16_bf16(kf[0], qr[d0], p0, 0, 0, 0); p1 = __builtin_amdgcn_mfma_f32_32x32x16_bf16(kf[1], qr[d0], p1, 0, 0, 0); \
      asm volatile("" : "+v"(p0), "+v"(p1)); } while (0)
#define PKV(L, H) (bf16x8){L[0], L[1], L[2], L[3], H[0], H[1], H[2], H[3]}
#define WGBAR() do { asm volatile("" ::: "memory"); __builtin_amdgcn_s_barrier(); asm volatile("" ::: "memory"); } while (0)
#define QKT(KBUF) do { int ka[4]; _Pragma("unroll") for (int d = 0; d < 4; ++d) ka[d] = kaddr[d] + (KBUF); _Pragma("unroll") for (int r = 0; r < 16; ++r) { p0[r] = 0.f; p1[r] = 0.f; } \
    { bf16x8 k0[2], k1[2], k2[2]; \
      KLOAD1(k0, KBUF, 0); KLOAD1(k1, KBUF, 1); KLOAD1(k2, KBUF, 2); \
      KWAIT(4); KMMA1(k0, 0); KLOAD1(k0, KBUF, 3); \
      KWAIT(4); KMMA1(k1, 1); KLOAD1(k1, KBUF, 4); \
      KWAIT(4); KMMA1(k2, 2); KLOAD1(k2, KBUF, 5); \
      KWAIT(4); KMMA1(k0, 3); KLOAD1(k0, KBUF, 6); \
      KWAIT(4); KMMA1(k1, 4); KLOAD1(k1, KBUF, 7); \
      KWAIT(4); KMMA1(k2, 5); \
      KWAIT(2); KMMA1(k0, 6); \
      KWAIT(0); KMMA1(k1, 7); } \
  } while (0)
#define TILE(buf, t) do { \
      \
    if (grp == 1) { if ((t) + 1 < NT) ISSUE_V(1 - (buf), ((t) + 1) * KVBLK); } else if ((t) + 2 < NT) ISSUE_K(kq == 32768 ? 0 : kq + 16384, ((t) + 2) * KVBLK);   \
    float pmax = p0[0]; \
    _Pragma("unroll") for (int r = 1; r < 16; ++r) pmax = fmaxf(pmax, p0[r]); \
    _Pragma("unroll") for (int r = 0; r < 16; ++r) pmax = fmaxf(pmax, p1[r]); \
    { auto rr = __builtin_amdgcn_permlane32_swap(__float_as_uint(pmax), __float_as_uint(pmax), false, false); pmax = fmaxf(__uint_as_float(rr[0]), __uint_as_float(rr[1])); } \
    float alpha = 1.f; \
    { const bool ok_ = ((t) > 0) ? __all(pmax - m_reg <= THR2) : __all(fabsf(pmax) <= THR2); \
      if (!__builtin_expect(ok_, 1)) { const float mn = ((t) > 0) ? fmaxf(m_reg, pmax) : pmax; alpha = ((t) > 0) ? __builtin_amdgcn_exp2f(m_reg - mn) : 1.f; m_reg = mn; } } \
    float ps = 0.f; \
    if (!__builtin_expect(__all(m_reg == 0.f), 1)) { \
      _Pragma("unroll") for (int r = 0; r < 16; ++r) { p0[r] -= m_reg; p1[r] -= m_reg; } } \
    _Pragma("unroll") for (int r = 0; r < 16; ++r) { p0[r] = __builtin_amdgcn_exp2f(p0[r]); ps += p0[r]; } \
    _Pragma("unroll") for (int r = 0; r < 16; ++r) { p1[r] = __builtin_amdgcn_exp2f(p1[r]); ps += p1[r]; } \
    { auto rr = __builtin_amdgcn_permlane32_swap(__float_as_uint(ps), __float_as_uint(ps), false, false); ps = __uint_as_float(rr[0]) + __uint_as_float(rr[1]); } \
    l_reg = l_reg * alpha + ps; \
    bf16x8 pa0, pa1, pa2, pa3; \
    PK4(p0, 0, pa0); PK4(p0, 8, pa1); PK4(p1, 0, pa2); PK4(p1, 8, pa3); \
    if (grp == 0) { if ((t) + 2 < NT) asm volatile("s_waitcnt vmcnt(4)" ::: "memory"); else asm volatile("s_waitcnt vmcnt(0)" ::: "memory"); }     \
    WGBAR(); \
      \
    if (__any(alpha < 1.f)) { if (hi == 0) al_l[r32] = alpha; asm volatile("s_waitcnt lgkmcnt(0)" ::: "memory"); \
      _Pragma("unroll") for (int r = 0; r < 16; ++r) { const float a_ = al_l[crow(r, hi)]; _Pragma("unroll") for (int d = 0; d < 8; ++d) o[d][r] *= a_; } } \
    const int vb_r = vbase + (buf) * 32768; \
    { s16x4 vl[4], vh[4]; \
      vl[0] = tr_read<0>(vb_r); vh[0] = tr_read<2048>(vb_r); vl[1] = tr_read<4096>(vb_r); vh[1] = tr_read<6144>(vb_r); vl[2] = tr_read<8192>(vb_r); vh[2] = tr_read<10240>(vb_r); \
      vl[3] = tr_read<12288>(vb_r); vh[3] = tr_read<14336>(vb_r); KWAIT(6); o[0] = __builtin_amdgcn_mfma_f32_32x32x16_bf16(pa0, PKV(vl[0], vh[0]), o[0], 0, 0, 0); \
      vl[0] = tr_read<512>(vb_r); vh[0] = tr_read<2560>(vb_r); KWAIT(6); o[0] = __builtin_amdgcn_mfma_f32_32x32x16_bf16(pa1, PKV(vl[1], vh[1]), o[0], 0, 0, 0); \
      vl[1] = tr_read<4608>(vb_r); vh[1] = tr_read<6656>(vb_r); KWAIT(6); o[0] = __builtin_amdgcn_mfma_f32_32x32x16_bf16(pa2, PKV(vl[2], vh[2]), o[0], 0, 0, 0); \
      vl[2] = tr_read<8704>(vb_r); vh[2] = tr_read<10752>(vb_r); KWAIT(6); o[0] = __builtin_amdgcn_mfma_f32_32x32x16_bf16(pa3, PKV(vl[3], vh[3]), o[0], 0, 0, 0); \
      vl[3] = tr_read<12800>(vb_r); vh[3] = tr_read<14848>(vb_r); KWAIT(6); o[1] = __builtin_amdgcn_mfma_f32_32x32x16_bf16(pa0, PKV(vl[0], vh[0]), o[1], 0, 0, 0); \
      vl[0] = tr_read<1024>(vb_r); vh[0] = tr_read<3072>(vb_r); KWAIT(6); o[1] = __builtin_amdgcn_mfma_f32_32x32x16_bf16(pa1, PKV(vl[1], vh[1]), o[1], 0, 0, 0); \
      vl[1] = tr_read<5120>(vb_r); vh[1] = tr_read<7168>(vb_r); KWAIT(6); o[1] = __builtin_amdgcn_mfma_f32_32x32x16_bf16(pa2, PKV(vl[2], vh[2]), o[1], 0, 0, 0); \
      vl[2] = tr_read<9216>(vb_r); vh[2] = tr_read<11264>(vb_r); KWAIT(6); o[1] = __builtin_amdgcn_mfma_f32_32x32x16_bf16(pa3, PKV(vl[3], vh[3]), o[1], 0, 0, 0); \
      vl[3] = tr_read<13312>(vb_r); vh[3] = tr_read<15360>(vb_r); KWAIT(6); o[2] = __builtin_amdgcn_mfma_f32_32x32x16_bf16(pa0, PKV(vl[0], vh[0]), o[2], 0, 0, 0); \
      vl[0] = tr_read<1536>(vb_r); vh[0] = tr_read<3584>(vb_r); KWAIT(6); o[2] = __builtin_amdgcn_mfma_f32_32x32x16_bf16(pa1, PKV(vl[1], vh[1]), o[2], 0, 0, 0); \
      vl[1] = tr_read<5632>(vb_r); vh[1] = tr_read<7680>(vb_r); KWAIT(6); o[2] = __builtin_amdgcn_mfma_f32_32x32x16_bf16(pa2, PKV(vl[2], vh[2]), o[2], 0, 0, 0); \
      vl[2] = tr_read<9728>(vb_r); vh[2] = tr_read<11776>(vb_r); KWAIT(6); o[2] = __builtin_amdgcn_mfma_f32_32x32x16_bf16(pa3, PKV(vl[3], vh[3]), o[2], 0, 0, 0); \
      vl[3] = tr_read<13824>(vb_r); vh[3] = tr_read<15872>(vb_r); KWAIT(6); o[3] = __builtin_amdgcn_mfma_f32_32x32x16_bf16(pa0, PKV(vl[0], vh[0]), o[3], 0, 0, 0); \
      vl[0] = tr_read<16384>(vb_r); vh[0] = tr_read<18432>(vb_r); KWAIT(6); o[3] = __builtin_amdgcn_mfma_f32_32x32x16_bf16(pa1, PKV(vl[1], vh[1]), o[3], 0, 0, 0); \
      vl[1] = tr_read<20480>(vb_r); vh[1] = tr_read<22528>(vb_r); KWAIT(6); o[3] = __builtin_amdgcn_mfma_f32_32x32x16_bf16(pa2, PKV(vl[2], vh[2]), o[3], 0, 0, 0); \
      vl[2] = tr_read<24576>(vb_r); vh[2] = tr_read<26624>(vb_r); KWAIT(6); o[3] = __builtin_amdgcn_mfma_f32_32x32x16_bf16(pa3, PKV(vl[3], vh[3]), o[3], 0, 0, 0); \
      vl[3] = tr_read<28672>(vb_r); vh[3] = tr_read<30720>(vb_r); KWAIT(6); o[4] = __builtin_amdgcn_mfma_f32_32x32x16_bf16(pa0, PKV(vl[0], vh[0]), o[4], 0, 0, 0); \
      vl[0] = tr_read<16896>(vb_r); vh[0] = tr_read<18944>(vb_r); KWAIT(6); o[4] = __builtin_amdgcn_mfma_f32_32x32x16_bf16(pa1, PKV(vl[1], vh[1]), o[4], 0, 0, 0); \
      vl[1] = tr_read<20992>(vb_r); vh[1] = tr_read<23040>(vb_r); KWAIT(6); o[4] = __builtin_amdgcn_mfma_f32_32x32x16_bf16(pa2, PKV(vl[2], vh[2]), o[4], 0, 0, 0); \
      vl[2] = tr_read<25088>(vb_r); vh[2] = tr_read<27136>(vb_r); KWAIT(6); o[4] = __builtin_amdgcn_mfma_f32_32x32x16_bf16(pa3, PKV(vl[3], vh[3]), o[4], 0, 0, 0); \
      vl[3] = tr_read<29184>(vb_r); vh[3] = tr_read<31232>(vb_r); KWAIT(6); o[5] = __builtin_amdgcn_mfma_f32_32x32x16_bf16(pa0, PKV(vl[0], vh[0]), o[5], 0, 0, 0); \
      vl[0] = tr_read<17408>(vb_r); vh[0] = tr_read<19456>(vb_r); KWAIT(6); o[5] = __builtin_amdgcn_mfma_f32_32x32x16_bf16(pa1, PKV(vl[1], vh[1]), o[5], 0, 0, 0); \
      vl[1] = tr_read<21504>(vb_r); vh[1] = tr_read<23552>(vb_r); KWAIT(6); o[5] = __builtin_amdgcn_mfma_f32_32x32x16_bf16(pa2, PKV(vl[2], vh[2]), o[5], 0, 0, 0); \
      vl[2] = tr_read<25600>(vb_r); vh[2] = tr_read<27648>(vb_r); KWAIT(6); o[5] = __builtin_amdgcn_mfma_f32_32x32x16_bf16(pa3, PKV(vl[3], vh[3]), o[5], 0, 0, 0); \
      vl[3] = tr_read<29696>(vb_r); vh[3] = tr_read<31744>(vb_r); KWAIT(6); o[6] = __builtin_amdgcn_mfma_f32_32x32x16_bf16(pa0, PKV(vl[0], vh[0]), o[6], 0, 0, 0); \
      vl[0] = tr_read<17920>(vb_r); vh[0] = tr_read<19968>(vb_r); KWAIT(6); o[6] = __builtin_amdgcn_mfma_f32_32x32x16_bf16(pa1, PKV(vl[1], vh[1]), o[6], 0, 0, 0); \
      vl[1] = tr_read<22016>(vb_r); vh[1] = tr_read<24064>(vb_r); KWAIT(6); o[6] = __builtin_amdgcn_mfma_f32_32x32x16_bf16(pa2, PKV(vl[2], vh[2]), o[6], 0, 0, 0); \
      vl[2] = tr_read<26112>(vb_r); vh[2] = tr_read<28160>(vb_r); KWAIT(6); o[6] = __builtin_amdgcn_mfma_f32_32x32x16_bf16(pa3, PKV(vl[3], vh[3]), o[6], 0, 0, 0); \
      vl[3] = tr_read<30208>(vb_r); vh[3] = tr_read<32256>(vb_r); KWAIT(6); o[7] = __builtin_amdgcn_mfma_f32_32x32x16_bf16(pa0, PKV(vl[0], vh[0]), o[7], 0, 0, 0); \
      KWAIT(4); o[7] = __builtin_amdgcn_mfma_f32_32x32x16_bf16(pa1, PKV(vl[1], vh[1]), o[7], 0, 0, 0); \
      KWAIT(2); o[7] = __builtin_amdgcn_mfma_f32_32x32x16_bf16(pa2, PKV(vl[2], vh[2]), o[7], 0, 0, 0); \
      KWAIT(0); o[7] = __builtin_amdgcn_mfma_f32_32x32x16_bf16(pa3, PKV(vl[3], vh[3]), o[7], 0, 0, 0); \
    } \
    SBAR(); QKT(kq); kq = (kq == 32768 ? 0 : kq + 16384);   \
    if (grp == 1) asm volatile("s_waitcnt vmcnt(0)" ::: "memory"); \
    WGBAR(); \
  } while (0)
#define PK4(P, BASE, OUT) do { unsigned a0 = cvtpk(P[BASE + 0], P[BASE + 1]), a1 = cvtpk(P[BASE + 2], P[BASE + 3]);   \
    unsigned b0 = cvtpk(P[BASE + 4], P[BASE + 5]), b1 = cvtpk(P[BASE + 6], P[BASE + 7]);                              \
    auto r0 = __builtin_amdgcn_permlane32_swap(a0, b0, false, false); auto r1 = __builtin_amdgcn_permlane32_swap(a1, b1, false, false); \
    v4u w = {r0[0], r1[0], r0[1], r1[1]}; OUT = *reinterpret_cast<bf16x8*>(&w); } while (0)
  if (grp == 0) { ISSUE_K(0, 0); ISSUE_K(16384, KVBLK); } else ISSUE_V(0, 0);
  asm volatile("s_waitcnt vmcnt(0)" ::: "memory"); WGBAR();
  f32x16 p0, p1;
  QKT(0);
  int kq = 16384;
  if (grp == 1) { WGBAR(); __builtin_amdgcn_s_setprio(1); }
  for (int t = 0; t < NT; t += 2) { TILE(0, t); TILE(1, t + 1); }
  if (grp == 0) WGBAR(); else __builtin_amdgcn_s_setprio(0);
#undef QKT
#undef PK4
#undef TILE
#undef ISSUE_K
#undef ISSUE_V
#undef KLOAD1
#undef KMMA1
#undef KWAIT
#undef PKV
#undef WGBAR
  if (hi == 0) li_l[r32] = l_reg; asm volatile("s_waitcnt lgkmcnt(0)" ::: "memory");
  float rli[16];
#pragma unroll
  for (int r = 0; r < 16; ++r) rli[r] = __builtin_amdgcn_rcpf(li_l[crow(r, hi)]);
  float* Ow = Ob + (long)(wid * 32) * LDO;
  if (!fin) {
#pragma unroll
    for (int r = 0; r < 16; ++r) { const int orow = crow(r, hi);
#pragma unroll
      for (int d0 = 0; d0 < 8; ++d0) Ow[(long)orow * LDO + d0 * 32 + r32] = o[d0][r] * rli[r]; }
  } else {
    const LAS float* cst = (const LAS float*)(lds + CST);
    const float lam = cst[256]; float sg[8];
#pragma unroll
    for (int d0 = 0; d0 < 8; ++d0) sg[d0] = cst[d0 * 32 + r32];
    unsigned char* wsb = *(unsigned char* const __attribute__((address_space(4)))*)((const __attribute__((address_space(4))) char*)__builtin_amdgcn_kernarg_segment_ptr() + 184);
    bf16* Ab = (bf16*)(wsb + A_ATTN + (((const unsigned char*)Ob - (wsb + A_OP) - 1024) >> 2));
    bf16* Aw = Ab + (long)(wid * 32) * 2048;
#pragma unroll
    for (int r = 0; r < 16; ++r) { const int orow = crow(r, hi); float ss = 0.f;
#pragma unroll
      for (int d0 = 0; d0 < 8; ++d0) { const float d = o[d0][r] * rli[r] - lam * Ow[(long)orow * LDO + d0 * 32 + r32]; o[d0][r] = d; ss += d * d; }
      ss += __shfl_xor(ss, 1); ss += __shfl_xor(ss, 2); ss += __shfl_xor(ss, 4); ss += __shfl_xor(ss, 8); ss += __shfl_xor(ss, 16);
      const float rs = 1.0f / sqrtf(ss * (1.f / 256.f) + LN_EPS);
#pragma unroll
      for (int d0 = 0; d0 < 8; ++d0) Aw[(long)orow * 2048 + d0 * 32 + r32] = (bf16)f2bf(o[d0][r] * rs * sg[d0]); }
  }
}
}

constexpr int NWAVES = 8, NPH = 13;
constexpr int RING_BYTES = 131072, MISC_OFF = 143360, LDS_BYTES = 147456;

struct Args { const float* in[22]; float* out; unsigned char* ws; int ph_lo, ph_hi; };
static_assert(sizeof(Args) == 22 * 8 + 8 + 8 + 8, "no padding");
static_assert(offsetof(Args, ws) == 184, "att2's final-pass epilogue re-reads Args::ws at byte 184 of the kernel arguments");

__device__ __forceinline__ void ln_row(const float* in, const float* gam, const float* bet, float* outf, bf16* outb, f32x2* stat, int lane) {
    const GAS f32x4* xr = (const GAS f32x4*)in + lane;
    f32x4 v[16]; float s = 0.f;
#pragma unroll
    for (int j = 0; j < 16; ++j) { v[j] = xr[64 * j]; s += (v[j].x + v[j].y) + (v[j].z + v[j].w); }
    const float mean = wave_sum(s) * (1.f / DM); float s2 = 0.f;
#pragma unroll
    for (int j = 0; j < 16; ++j) { v[j] = v[j] - mean; s2 += (v[j].x * v[j].x + v[j].y * v[j].y) + (v[j].z * v[j].z + v[j].w * v[j].w); }
    const float rstd = 1.f / sqrtf(wave_sum(s2) * (1.f / DM) + LN_EPS);
    if (stat && lane == 0) *stat = (f32x2){mean, rstd};
    const GAS f32x4* gr = (const GAS f32x4*)gam + lane; const GAS f32x4* br = (const GAS f32x4*)bet + lane;
    GAS f32x4* of = (GAS f32x4*)outf + lane; GAS v2u* ob = (GAS v2u*)outb + lane;
#pragma unroll
    for (int j = 0; j < 16; ++j) { const f32x4 o = v[j] * rstd * gr[64 * j] + br[64 * j]; if (outf) of[64 * j] = o;
        if (outb) { v2u w; w.x = pk2(o.x, o.y); w.y = pk2(o.z, o.w); ob[64 * j] = w; } }
}
__device__ __forceinline__ void ln_rows_f(const float* in, const float* gam, const float* bet, bf16* outb, f32x2* stat, int first, int step, int lane) {
    if (first >= M) return;
    f32x4 nx[16];
    { const GAS f32x4* xr = (const GAS f32x4*)(in + (size_t)first * DM) + lane;
#pragma unroll
      for (int j = 0; j < 16; ++j) nx[j] = xr[64 * j]; }
    const GAS f32x4* gr = (const GAS f32x4*)gam + lane; const GAS f32x4* br = (const GAS f32x4*)bet + lane;
    for (int m = first; m < M; m += step) {
        f32x4 v[16]; float s = 0.f;
#pragma unroll
        for (int j = 0; j < 16; ++j) { v[j] = nx[j]; s += (v[j].x + v[j].y) + (v[j].z + v[j].w); }
        { const int mn = m + step < M ? m + step : m; const GAS f32x4* xr = (const GAS f32x4*)(in + (size_t)mn * DM) + lane;
#pragma unroll
          for (int j = 0; j < 16; ++j) nx[j] = xr[64 * j]; }
        const float mean = wave_sum(s) * (1.f / DM); float s2 = 0.f;
#pragma unroll
        for (int j = 0; j < 16; ++j) { v[j] = v[j] - mean; s2 += (v[j].x * v[j].x + v[j].y * v[j].y) + (v[j].z * v[j].z + v[j].w * v[j].w); }
        const float rstd = 1.f / sqrtf(wave_sum(s2) * (1.f / DM) + LN_EPS);
        if (lane == 0) stat[m] = (f32x2){mean, rstd};
        GAS v2u* ob = (GAS v2u*)(outb + (size_t)m * DM) + lane;
#pragma unroll
        for (int j = 0; j < 16; ++j) { const f32x4 o = v[j] * rstd * gr[64 * j] + br[64 * j]; v2u w; w.x = pk2(o.x, o.y); w.y = pk2(o.z, o.w); ob[64 * j] = w; }
    }
}
__device__ __forceinline__ void ln_rows_h(const _Float16* in, const float* gam, const float* bet, float* outf, bf16* outb, f32x2* stat, int first, int step, int lane) {
    if (first >= M) return;
    f32x4 g[16], b[16];
    { const GAS f32x4* gr = (const GAS f32x4*)gam + 2 * lane; const GAS f32x4* br = (const GAS f32x4*)bet + 2 * lane;
#pragma unroll
      for (int j = 0; j < 8; ++j) { g[2 * j] = gr[128 * j]; g[2 * j + 1] = gr[128 * j + 1]; b[2 * j] = br[128 * j]; b[2 * j + 1] = br[128 * j + 1]; } }
    h16x8 raw[8];
    { const GAS h16x8* xr = (const GAS h16x8*)(in + (size_t)first * DM) + lane;
#pragma unroll
      for (int j = 0; j < 8; ++j) raw[j] = xr[64 * j]; }
    for (int m = first; m < M; m += step) {
        f32x4 v[16]; float s = 0.f;
#pragma unroll
        for (int j = 0; j < 8; ++j) { const h16x8 h = raw[j];
            v[2 * j] = __builtin_convertvector(__builtin_shufflevector(h, h, 0, 1, 2, 3), f32x4); v[2 * j + 1] = __builtin_convertvector(__builtin_shufflevector(h, h, 4, 5, 6, 7), f32x4);
            s += ((v[2 * j].x + v[2 * j].y) + (v[2 * j].z + v[2 * j].w)) + ((v[2 * j + 1].x + v[2 * j + 1].y) + (v[2 * j + 1].z + v[2 * j + 1].w)); }
        { const int mn = m + step < M ? m + step : m; const GAS h16x8* xr = (const GAS h16x8*)(in + (size_t)mn * DM) + lane;
#pragma unroll
          for (int j = 0; j < 8; ++j) raw[j] = xr[64 * j]; }
        const float mean = wave_sum(s) * (1.f / DM); float s2 = 0.f;
#pragma unroll
        for (int j = 0; j < 16; ++j) { v[j] = v[j] - mean; s2 += (v[j].x * v[j].x + v[j].y * v[j].y) + (v[j].z * v[j].z + v[j].w * v[j].w); }
        const float rstd = 1.f / sqrtf(wave_sum(s2) * (1.f / DM) + LN_EPS);
        if (stat && lane == 0) stat[m] = (f32x2){mean, rstd};
        GAS f32x4* of = (GAS f32x4*)(outf + (size_t)m * DM) + 2 * lane; GAS v4u* ob = (GAS v4u*)(outb + (size_t)m * DM) + lane;
#pragma unroll
        for (int j = 0; j < 8; ++j) { const f32x4 o0 = v[2 * j] * rstd * g[2 * j] + b[2 * j], o1 = v[2 * j + 1] * rstd * g[2 * j + 1] + b[2 * j + 1];
            if (outf) { of[128 * j] = o0; of[128 * j + 1] = o1; }
            if (outb) { v4u w; w.x = pk2(o0.x, o0.y); w.y = pk2(o0.z, o0.w); w.z = pk2(o1.x, o1.y); w.w = pk2(o1.z, o1.w); ob[64 * j] = w; } }
    }
}
__device__ __forceinline__ void transpose_item(const float* W, int K, int N, bf16* WT, int k0, int n0, int drow0, LAS float* scr, int lane) {
    const int lk = lane >> 4, ln = (lane & 15) * 4;
    const GAS float* src = (const GAS float*)W + (size_t)(k0 + lk) * N + n0 + ln;
    f32x4 v[16];
#pragma unroll
    for (int i = 0; i < 16; ++i) v[i] = *(const GAS f32x4*)(src + (size_t)(4 * i) * N);
#pragma unroll
    for (int i = 0; i < 16; ++i) { LAS float* d = scr + (4 * i + lk) * 65 + ln; d[0] = v[i].x; d[1] = v[i].y; d[2] = v[i].z; d[3] = v[i].w; }
    LDS_WAIT(); asm volatile("" ::: "memory");
    const int c = lane & 7;
#pragma unroll
    for (int j = 0; j < 8; ++j) { const int n = (lane >> 3) + 8 * j; const LAS float* s = scr + (8 * c) * 65 + n;
        v4u o; o.x = pk2(s[0 * 65], s[1 * 65]); o.y = pk2(s[2 * 65], s[3 * 65]); o.z = pk2(s[4 * 65], s[5 * 65]); o.w = pk2(s[6 * 65], s[7 * 65]);
        *(GAS v4u*)(WT + (size_t)(drow0 + n) * K + k0 + 8 * c) = o; }
    LDS_WAIT(); asm volatile("" ::: "memory");
}
struct TItem { const GAS float* src; GAS bf16* dst; int N, K; };
__device__ __forceinline__ TItem titem_make(const float* W, int K, int N, bf16* WT, int k0, int n0, int drow0, int lane) {
    TItem P; P.src = (const GAS float*)W + (size_t)(k0 + 2 * (lane >> 4)) * N + n0 + (lane & 15) * 4;
    P.dst = (GAS bf16*)WT + (size_t)(drow0 + (lane >> 3)) * K + k0 + 8 * (lane & 7); P.N = N; P.K = K; return P;
}
__device__ __forceinline__ void titem_load(const TItem& P, f32x4 (&v)[16]) {
#pragma unroll
    for (int a = 0; a < 8; ++a) { v[2 * a] = *(const GAS f32x4*)(P.src + (size_t)(8 * a) * P.N); v[2 * a + 1] = *(const GAS f32x4*)(P.src + (size_t)(8 * a + 1) * P.N); }
}
__device__ __forceinline__ void titem_finish(const TItem& P, const f32x4 (&v)[16], LAS float* scrf, int lane) {
    LAS unsigned* scr = (LAS unsigned*)scrf;
    const int lk = lane >> 4, ln = (lane & 15) * 4;
#pragma unroll
    for (int a = 0; a < 8; ++a) { LAS unsigned* d = scr + (4 * a + lk) * 66 + ln;
        v2u w0, w1; w0.x = pk2(v[2 * a].x, v[2 * a + 1].x); w0.y = pk2(v[2 * a].y, v[2 * a + 1].y); w1.x = pk2(v[2 * a].z, v[2 * a + 1].z); w1.y = pk2(v[2 * a].w, v[2 * a + 1].w);
        *(LAS v2u*)d = w0; *(LAS v2u*)(d + 2) = w1; }
    LDS_WAIT(); asm volatile("" ::: "memory");
    const int c = lane & 7;
#pragma unroll
    for (int j = 0; j < 8; ++j) { const LAS unsigned* s = scr + (4 * c) * 66 + (lane >> 3) + 8 * j;
        v4u o; o.x = s[0]; o.y = s[66]; o.z = s[132]; o.w = s[198];
        *(GAS v4u*)(P.dst + (size_t)(8 * j) * P.K) = o; }
    LDS_WAIT(); asm volatile("" ::: "memory");
}
__constant__ float INV_FREQ[16] = {1.0f, 0.440366596f, 0.193922743f, 0.0853971019f, 0.0376060307f, 0.016560439f, 0.00729266461f, 0.00321144587f,
                                   0.00141421356f, 0.000622772379f, 0.000274248188f, 0.000120769735f, 5.3182961e-05f, 2.34199997e-05f, 1.03133862e-05f, 4.54167048e-06f};
constexpr float W32C[16] = {1.0f, 0.980785251f, 0.923879504f, 0.831469595f, 0.707106769f, 0.555570245f, 0.382683426f, 0.195090324f, 0.0f, -0.195090324f, -0.382683426f, -0.555570245f, -0.707106769f, -0.831469595f, -0.923879504f, -0.980785251f};
constexpr float W32S[16] = {0.0f, 0.195090324f, 0.382683426f, 0.555570245f, 0.707106769f, 0.831469595f, 0.923879504f, 0.980785251f, 1.0f, 0.980785251f, 0.923879504f, 0.831469595f, 0.707106769f, 0.555570245f, 0.382683426f, 0.195090324f};

__device__ __forceinline__ int rep_fence() { asm volatile("s_nop 0" ::: "memory"); return 1; }
__global__ void __launch_bounds__(NWAVES * 64, 2) fwd(Args args) {
    extern __shared__ __attribute__((aligned(16))) unsigned char lds[];
    LAS unsigned char* L = (LAS unsigned char*)lds;
    volatile LAS unsigned* MISC = (volatile LAS unsigned*)(L + MISC_OFF);
    int wave = __builtin_amdgcn_readfirstlane(threadIdx.x >> 6); asm volatile("" : "+s"(wave));
    const int G = gridDim.x, bx = blockIdx.x;
    const int gw = bx * NWAVES + wave, NGW = G * NWAVES;
    const int NGT = G * NWAVES * 64;
#define LATE_DECODE(itv, P) do { int r = (itv); \
            if (r < I_AO) { const int kb = r % 32, nb = r / 32; P = titem_make(w_attn_o, 2048, 4096, WaoT, 64 * kb, 64 * nb, 64 * nb, lane_c); break; } r -= I_AO; \
            if (r < I_FO) { const int kb = r % 32, nb = r / 32; P = titem_make(w_fourier, 2048, 4096, WfT, 64 * kb, 64 * nb, 64 * nb, lane_c); break; } r -= I_FO; \
            if (r < I_G) { const int kb = r % 64, nb = r / 64; const int n0 = 64 * nb, half = n0 >> 12, j = n0 & 4095; const int dr = (j >> 7) * 256 + half * 128 + (j & 127); \
                           P = titem_make(w_gate, 4096, 8192, WgT, 64 * kb, n0, dr, lane_c); break; } r -= I_G; \
            if (r < I_MX) { const int kb = r % 64, nb = r / 64; P = titem_make(w_mix_out, 4096, 4096, WmT, 64 * kb, 64 * nb, 64 * nb, lane_c); break; } r -= I_MX; \
            { const int kb = r % 64, nb = r / 64; const int n0 = 64 * nb, half = n0 >= DFF ? 1 : 0, j = n0 - half * DFF; const int dr = (j >> 7) * 256 + half * 128 + (j & 127); \
                            P = titem_make(w_up, 4096, DFF2, WupT, 64 * kb, n0, dr, lane_c); } \
    } while (0)
#define LATE_CONVERT() do { \
        __syncthreads(); const int lane_c = lane_id_fresh(); LAS float* scr = (LAS float*)(L + wave * 17408); \
        constexpr int I_AO = 32 * 64, I_FO = 32 * 64, I_G = 64 * 128, I_MX = 64 * 64, I_UP = 64 * 344; \
        constexpr int NITEMS = I_AO + I_FO + I_G + I_MX + I_UP; \
        int it = gw; asm volatile("" : "+s"(it));   \
        if (it < NITEMS) { \
            TItem P; f32x4 v[16]; LATE_DECODE(it, P); titem_load(P, v); \
            for (;;) { \
                const int it2 = it + NGW; const bool more = it2 < NITEMS; \
                TItem P2; f32x4 v2[16]; LATE_DECODE(more ? it2 : it, P2); titem_load(P2, v2); \
                titem_finish(P, v, scr, lane_c); \
                if (!more) break; \
                P = P2; it = it2; \
                _Pragma("unroll") for (int i = 0; i < 16; ++i) v[i] = v2[i]; \
            } \
        } \
        asm volatile("s_waitcnt vmcnt(0)" ::: "memory"); __syncthreads(); \
    } while (0)
#define PHASE_LANES() const int lane = lane_id_fresh(); const int tid = wave * 64 + lane; const int gt = bx * NWAVES * 64 + tid; (void)tid; (void)gt; (void)lane
#define KARG ((const __attribute__((address_space(4))) Args*)__builtin_amdgcn_kernarg_segment_ptr())
#define WSB (KARG->ws)
#define OUT (KARG->out)
#define x_in (KARG->in[0])
#define ln_emb_g (KARG->in[1])
#define ln_emb_b (KARG->in[2])
#define w_in (KARG->in[3])
#define lq1 (KARG->in[4])
#define lk1 (KARG->in[5])
#define lq2 (KARG->in[6])
#define lk2 (KARG->in[7])
#define subln_g (KARG->in[8])
#define w_attn_o (KARG->in[9])
#define w_fourier (KARG->in[10])
#define w_gate (KARG->in[11])
#define b_gate (KARG->in[12])
#define w_mix_out (KARG->in[13])
#define ln1_g (KARG->in[14])
#define ln1_b (KARG->in[15])
#define w_up (KARG->in[16])
#define conv_w (KARG->in[17])
#define conv_b (KARG->in[18])
#define w_down (KARG->in[19])
#define ln2_g (KARG->in[20])
#define ln2_b (KARG->in[21])
#define WdT ((bf16*)(WSB + W_DT))
#define WmT ((bf16*)(WSB + W_MT))
#define WaoT ((bf16*)(WSB + W_AOT))
#define WfT ((bf16*)(WSB + W_FT))
#define WgT ((bf16*)(WSB + W_GT))
#define WinT ((bf16*)(WSB + W_INT))
#define WupT ((bf16*)(WSB + W_UPT))
#define DFT256 ((bf16*)(WSB + TAB_DFT256))
#define DFTC ((bf16*)(WSB + TAB_DFTC))
#define TW ((f32x2*)(WSB + TAB_TW))
#define ROPEC ((float*)(WSB + TAB_ROPEC))
#define ROPES ((float*)(WSB + TAB_ROPES))
#define HB ((bf16*)(WSB + A_HB))
#define UQKV ((bf16*)(WSB + A_UQKV))
#define UFT ((bf16*)(WSB + A_UFT))
#define TT ((bf16*)(WSB + A_T))
#define OP ((float*)(WSB + A_OP))
#define ZT ((bf16*)(WSB + A_ZT))
#define ATTN ((bf16*)(WSB + A_ATTN))
#define YF ((bf16*)(WSB + A_YF))
#define YA ((bf16*)(WSB + A_YA))
#define YFO ((bf16*)(WSB + A_YFO))
#define MIX ((bf16*)(WSB + A_MIX))
#define R1H ((_Float16*)(WSB + A_R1H))
#define R2H ((_Float16*)(WSB + A_R2H))
#define ABUF ((bf16*)(WSB + A_A))
#define ACT ((bf16*)(WSB + WS_ACT))

    { const int l0 = lane_id_fresh(); if (wave == 0 && l0 < 8) MISC[l0] = 0u; }
    __syncthreads();
    XcdBarrier bar; bar.bar = (unsigned*)(WSB + WS_CTL) + CW_BAR; bar.x = 0; bar.st = nullptr;
    if (!MK_PER_PHASE) bar = xcd_barrier_post((unsigned*)(WSB + WS_CTL) + CW_BAR, MISC, wave);
    const int lo = KARG->ph_lo, hi = KARG->ph_hi;
#ifndef PH_MASK
#define PH_MASK 0x1fff
#endif
#ifndef REP_MASK
#define REP_MASK 0x0
#endif
#define REPS(k) for (int rep_ = 0; rep_ < (((REP_MASK) >> (k)) & 1) + 1; rep_ += rep_fence())
#define IN(k) ((((PH_MASK) >> (k)) & 1) && lo <= (k) && (k) < hi)
#define SEAM(k) do { if (IN((k) + 1)) xcd_barrier(bar, wave); } while (0)

    if (IN(0)) { PHASE_LANES();
        REPS(0) {
        ln_rows_f(x_in, ln_emb_g, ln_emb_b, HB, (f32x2*)(WSB + WS_STAT0), gw, NGW, lane);
        LAS float* scr = (LAS float*)(L + wave * 17408);
        { int it = gw;
          if (it < 64 * 128) {
            TItem P = titem_make(w_in, 4096, 8192, WinT, 64 * (it % 64), 64 * (it / 64), 64 * (it / 64), lane); f32x4 v[16]; titem_load(P, v);
            for (;;) {
                const int it2 = it + NGW; const bool more = it2 < 64 * 128; const int itl = more ? it2 : it;
                TItem P2 = titem_make(w_in, 4096, 8192, WinT, 64 * (itl % 64), 64 * (itl / 64), 64 * (itl / 64), lane); f32x4 v2[16]; titem_load(P2, v2);
                titem_finish(P, v, scr, lane);
                if (!more) break;
                P = P2; it = it2;
#pragma unroll
                for (int i = 0; i < 16; ++i) v[i] = v2[i];
            }
          } }
        for (int i = gt; i < 512 * 256; i += NGT) { const int r = i >> 8, c = i & 255; float s, cs; sincos2pi((double)(((r & 255) * c) & 255) * (1.0 / 256.0), s, cs);
            DFT256[i] = (bf16)f2bf(r < 256 ? cs : -s); }
        for (int i = gt; i < 256 * 512; i += NGT) { const int cp = i >> 9, kap = i & 511; float s, cs; sincos2pi((double)(((kap & 255) * cp) & 255) * (1.0 / 256.0), s, cs);
            DFTC[i] = (bf16)f2bf(kap < 256 ? cs : s); }
        for (int i = gt; i < 8192; i += NGT) { float s, cs; sincos2pi((double)i * (1.0 / 8192.0), s, cs); TW[i] = (f32x2){cs, s}; }
        for (int i = gt; i < 8192 * 16; i += NGT) { const int pos = i >> 4, f = i & 15; const float ang = (float)pos * INV_FREQ[f]; float s, cs; sincos2pi((double)ang * 0.15915494309189533577, s, cs);
            ROPEC[i] = cs; ROPES[i] = s; }
        }
        SEAM(0);
    }
    if (IN(1)) { PHASE_LANES();
        REPS(1) {
        { pg8::Gemm g{HB, WinT, 4096u, 4096u, 4096}; pg8::StaticOrder S; S.init(M, NQKV, G, bx); pg8::EpiBf16Q E{UQKV, (unsigned)NQKV, att::SCALE * 1.4426950408889634f, 8, 16, ROPEC, ROPES};
          pg8::gemm_phase<pg8::EpiBf16Q, pg8::AddrPlain>(L, g, S, E, wave); }
        { pg8::Gemm g{WinT + (size_t)NQKV * 4096, HB, 4096u, 32u * 4096u, 4096}; pg8::StaticOrder S; S.init(FW, M, G, bx); pg8::EpiBf16 E{UFT, (unsigned)M};
          pg8::gemm_phase<pg8::EpiBf16, pg8::AddrF1>(L, g, S, E, wave); }
        }
        SEAM(1);
    }
    if (IN(2)) { PHASE_LANES();
        REPS(14) { pg8::Gemm g{DFT256, UFT, 256u, 16384u, 256}; pg8::StaticOrder S; S.init(512, 131072, G, bx); pg8::EpiBf16 E{TT, 131072u};
          pg8::gemm_phase<pg8::EpiBf16, pg8::AddrF2>(L, g, S, E, wave); }
        SEAM(2);
    }
    if (IN(3)) { PHASE_LANES();
#ifndef NO_ATT
#if ATT_V256
        float lam;
        { const float p1 = lq1[lane] * lk1[lane] + lq1[lane + 64] * lk1[lane + 64], p2 = lq2[lane] * lk2[lane] + lq2[lane + 64] * lk2[lane + 64];
          lam = expf(wave_sum(p1)) - expf(wave_sum(p2)) + LAMBDA_INIT; }
        { LAS float* cst = (LAS float*)(L + att2::CST); if (tid < 256) cst[tid] = subln_g[tid] * (1.0f - LAMBDA_INIT); if (tid == 256) cst[256] = lam; }
        __syncthreads();
        int slot = 0; const int my_slot = (bx * 4) / G;
        REPS(3) for (int Lu = bx; Lu < 512; Lu += G) {
            const int vh = (Lu >> 8) * 8 + (Lu & 7), qb = (Lu & 255) >> 3;
            const int b = vh >> 3, h = vh & 7;
            const bf16* Vh = UQKV + (size_t)(b * SEQ) * NQKV + 4096 + h * 256;
            float* Ob = OP + (size_t)(b * SEQ + qb * 256) * 4096 + h * 512 + 256;
            for (int c = 1; c >= 0; --c, ++slot) {
                if (slot == my_slot) LATE_CONVERT();
                const bf16* Qb = UQKV + (size_t)(b * SEQ + qb * 256) * NQKV + h * 256 + c * 128;
                const bf16* Kh = UQKV + (size_t)(b * SEQ) * NQKV + 2048 + h * 256 + c * 128;
                att2::attn_body(Qb, Kh, Vh, Ob, SEQ, L, wave, c == 0);
            }
        }
        asm volatile("s_waitcnt vmcnt(0)" ::: "memory"); __syncthreads();
        if (slot <= my_slot) LATE_CONVERT();
#else
        REPS(3) for (int Lu = bx; Lu < 2048; Lu += G) {
            const int vh = (Lu >> 8) * 8 + (Lu & 7), qb = (Lu & 255) >> 3;
            const int b = vh >> 5, h = (vh >> 2) & 7, c = (vh >> 1) & 1, j = vh & 1;
            const bf16* Qb = UQKV + (size_t)(b * SEQ + qb * 256) * NQKV + h * 256 + c * 128;
            const bf16* Kh = UQKV + (size_t)(b * SEQ) * NQKV + 2048 + h * 256 + c * 128;
            const bf16* Vh = UQKV + (size_t)(b * SEQ) * NQKV + 4096 + h * 256 + j * 128;
            float* Ob = OP + (size_t)(b * SEQ + qb * 256) * 4096 + h * 512 + c * 256 + j * 128;
            att::attn_dense_body(Qb, Kh, Vh, Ob, SEQ, (char*)lds, wave);
        }
#endif
#endif
#ifndef NO_FFT
        constexpr float FSCALE = 0.00069053396600248786f;
        const int lane_f = lane_id_fresh();
        REPS(13) for (int task = gw; task < 16384; task += NGW) {
            const int cq = task & 3, k2 = (task >> 2) & 255, b = (task >> 10) & 1, g = task >> 11, c = cq * 64 + lane_f;
            const bf16* pre = TT + (size_t)k2 * 131072 + (size_t)((g * 2 + b) * 32) * 256 + c;
            const bf16* pim = pre + (size_t)256 * 131072;
            float xr[32], xi[32];
#pragma unroll
            for (int n1 = 0; n1 < 32; ++n1) { const float a = bf2f(pre[n1 * 256]), bb = bf2f(pim[n1 * 256]); const f32x2 w = TW[n1 * k2];
                xr[n1] = a * w.x + bb * w.y; xi[n1] = bb * w.x - a * w.y; }
#pragma unroll
            for (int hh = 16; hh >= 1; hh >>= 1) {
#pragma unroll
                for (int blk = 0; blk < 32; blk += 2 * hh) {
#pragma unroll
                    for (int jj = 0; jj < hh; ++jj) { const int i0 = blk + jj, i1 = i0 + hh; const float wc = W32C[jj * (16 / hh)], wsn = W32S[jj * (16 / hh)];
                        const float ar = xr[i0], ai = xi[i0], br = xr[i1], bi = xi[i1];
                        xr[i0] = ar + br; xi[i0] = ai + bi; const float dr = ar - br, di = ai - bi;
                        xr[i1] = dr * wc + di * wsn; xi[i1] = di * wc - dr * wsn; }
                }
            }
            bf16* zo = ZT + (size_t)(b * SEQ + k2) * 4096 + g * 512 + c;
#pragma unroll
            for (int p = 0; p < 32; ++p) { const int k1 = ((p & 1) << 4) | ((p & 2) << 2) | (p & 4) | ((p & 8) >> 2) | ((p & 16) >> 4);
                zo[(size_t)k1 * 256 * 4096] = (bf16)f2bf(xr[p] * FSCALE); zo[(size_t)k1 * 256 * 4096 + 256] = (bf16)f2bf(xi[p] * FSCALE); }
        }
#endif
        SEAM(3);
    }
    if (IN(4)) { PHASE_LANES();
        REPS(4) {
        { pg8::Gemm g{ZT, DFTC, 4096u, 512u, 512}; pg8::StaticOrder S; S.init(M, 2048, G, bx); pg8::EpiBf16 E{YF, 2048u};
          pg8::gemm_phase<pg8::EpiBf16, pg8::AddrF4>(L, g, S, E, wave); }
        }
        SEAM(4);
    }
    if (IN(5)) { PHASE_LANES();
        REPS(5) {
        { pg8::Gemm g{ATTN, WaoT, 2048u, 2048u, 2048}; pg8::StaticOrder S; S.init(M, 4096, G, bx); pg8::EpiBf16 E{YA, 4096u};
          pg8::gemm_phase<pg8::EpiBf16, pg8::AddrPlain>(L, g, S, E, wave); }
        { pg8::Gemm g{YF, WfT, 2048u, 2048u, 2048}; pg8::StaticOrder S; S.init(M, 4096, G, bx); pg8::EpiBf16 E{YFO, 4096u};
          pg8::gemm_phase<pg8::EpiBf16, pg8::AddrPlain>(L, g, S, E, wave); }
        }
        SEAM(5);
    }
    if (IN(6)) { PHASE_LANES();
        REPS(6) {
        pg8::Gemm g{HB, WgT, 4096u, 4096u, 4096}; pg8::StaticOrder S; S.init(M, 8192, G, bx); pg8::EpiGateMix E{YA, YFO, b_gate, MIX};
        pg8::gemm_phase<pg8::EpiGateMix, pg8::AddrPlain>(L, g, S, E, wave);
        }
        SEAM(6);
    }
    if (IN(7)) { PHASE_LANES();
        pg8::Gemm g{MIX, WmT, 4096u, 4096u, 4096}; pg8::StaticOrder S; S.init(M, 4096, G, bx); pg8::EpiResLN<false> E{R1H, x_in, (const f32x2*)(WSB + WS_STAT0), ln_emb_g, ln_emb_b, 4096u, ALPHA};
        pg8::gemm_phase<pg8::EpiResLN<false>, pg8::AddrPlain>(L, g, S, E, wave);
        SEAM(7);
    }
    if (IN(8)) { PHASE_LANES();
        ln_rows_h(R1H, ln1_g, ln1_b, nullptr, HB, (f32x2*)(WSB + WS_STAT1), gw, NGW, lane);
        SEAM(8);
    }
    if (IN(9)) { PHASE_LANES();
        REPS(9) {
        pg8::Gemm g{HB, WupT, 4096u, 4096u, 4096}; pg8::StaticOrder S; S.init(M, DFF2, G, bx); pg8::EpiConv E{ACT, (float*)(WSB + WS_HALO), conv_w, conv_b, (unsigned)(uintptr_t)(L + RING_BYTES)};
        pg8::gemm_phase<pg8::EpiConv, pg8::AddrPlain>(L, g, S, E, wave);
        }
        { constexpr int NU = (M / 256) * (DFF2 / 256); const int rem = NU % G;
          if (rem == 0 || bx >= rem) {
            const int idx = (rem == 0 ? bx : bx - rem) * NWAVES + wave, cnt = (rem == 0 ? G : G - rem) * NWAVES;
            __syncthreads(); const int lane_c = lane_id_fresh(); LAS float* scr = (LAS float*)(L + wave * 17408);
            int it = idx;
            if (it < 172 * 64) {
                TItem P = titem_make(w_down, DFF, 4096, WdT, 64 * (it % 172), 64 * (it / 172), 64 * (it / 172), lane_c); f32x4 v[16]; titem_load(P, v);
                for (;;) {
                    const int it2 = it + cnt; const bool more = it2 < 172 * 64; const int itl = more ? it2 : it;
                    TItem P2 = titem_make(w_down, DFF, 4096, WdT, 64 * (itl % 172), 64 * (itl / 172), 64 * (itl / 172), lane_c); f32x4 v2[16]; titem_load(P2, v2);
                    titem_finish(P, v, scr, lane_c);
                    if (!more) break;
                    P = P2; it = it2;
#pragma unroll
                    for (int i = 0; i < 16; ++i) v[i] = v2[i];
                }
            }
            asm volatile("s_waitcnt vmcnt(0)" ::: "memory");
          } }
        SEAM(9);
    }
    if (IN(10)) { PHASE_LANES();
        constexpr int NCC = DFF / 4;
        const float* HL = (const float*)(WSB + WS_HALO);
        for (int t = gt; t < 62 * NCC; t += NGT) {
            const int cc = t % NCC, bd = t / NCC, j0 = cc * 4, pmA = (bd / 31) * 32 + (bd % 31), pmB = pmA + 1;
            const f32x4 wg0 = *(const f32x4*)(conv_w + j0), wg1 = *(const f32x4*)(conv_w + DFF2 + j0), wg2 = *(const f32x4*)(conv_w + 2 * DFF2 + j0), bg = *(const f32x4*)(conv_b + j0);
            const f32x4 wv0 = *(const f32x4*)(conv_w + DFF + j0), wv1 = *(const f32x4*)(conv_w + DFF2 + DFF + j0), wv2 = *(const f32x4*)(conv_w + 2 * DFF2 + DFF + j0), bv = *(const f32x4*)(conv_b + DFF + j0);
            const float* hA = HL + (size_t)pmA * 4 * DFF2 + j0; const float* hB = HL + (size_t)pmB * 4 * DFF2 + j0;
            const f32x4 g254 = *(const f32x4*)(hA + 2 * DFF2), g255 = *(const f32x4*)(hA + 3 * DFF2), g0 = *(const f32x4*)(hB), g1 = *(const f32x4*)(hB + DFF2);
            const f32x4 v254 = *(const f32x4*)(hA + 2 * DFF2 + DFF), v255 = *(const f32x4*)(hA + 3 * DFF2 + DFF), v0 = *(const f32x4*)(hB + DFF), v1 = *(const f32x4*)(hB + DFF2 + DFF);
            { const f32x4 cg = g254 * wg0 + g255 * wg1 + g0 * wg2 + bg, cv = v254 * wv0 + v255 * wv1 + v0 * wv2 + bv;
              v2u w; w.x = pk2(cg.x * fast_sigmoid(cg.x) * cv.x, cg.y * fast_sigmoid(cg.y) * cv.y); w.y = pk2(cg.z * fast_sigmoid(cg.z) * cv.z, cg.w * fast_sigmoid(cg.w) * cv.w);
              *(v2u*)(ACT + (size_t)(pmA * 256 + 255) * DFF + j0) = w; }
            { const f32x4 cg = g255 * wg0 + g0 * wg1 + g1 * wg2 + bg, cv = v255 * wv0 + v0 * wv1 + v1 * wv2 + bv;
              v2u w; w.x = pk2(cg.x * fast_sigmoid(cg.x) * cv.x, cg.y * fast_sigmoid(cg.y) * cv.y); w.y = pk2(cg.z * fast_sigmoid(cg.z) * cv.z, cg.w * fast_sigmoid(cg.w) * cv.w);
              *(v2u*)(ACT + (size_t)(pmB * 256) * DFF + j0) = w; }
        }
        SEAM(10);
    }
    if (IN(11)) { PHASE_LANES();
        pg8::Gemm g{ACT, WdT, (unsigned)DFF, (unsigned)DFF, DFF}; pg8::StaticOrder S; S.init(M, 4096, G, bx); pg8::EpiResLN<true> E{R2H, R1H, (const f32x2*)(WSB + WS_STAT1), ln1_g, ln1_b, 4096u, ALPHA};
        pg8::gemm_phase<pg8::EpiResLN<true>, pg8::AddrPlain>(L, g, S, E, wave);
        SEAM(11);
    }
    if (IN(12)) { PHASE_LANES();
        ln_rows_h(R2H, ln2_g, ln2_b, OUT, nullptr, nullptr, gw, NGW, lane);
    }
#undef IN
#undef SEAM
}

extern "C" void kernel_launch(void* const* d_in, const int* in_sizes, int n_in, void* d_out, int out_size, void* d_ws, size_t ws_size, hipStream_t stream) {
    static int grid = 0;
    if (grid == 0) {
        if (n_in != 22 || in_sizes[0] != M * DM || out_size != M * DM || ws_size < WS_END) {
            fprintf(stderr, "kernel_launch: unexpected shapes: n_in %d in0 %d out %d ws %zu (need %zu); nothing launched\n", n_in, n_in > 0 ? in_sizes[0] : -1, out_size, ws_size, (size_t)WS_END); grid = -1; return; }
        int dev = 0, cus = 0, per_cu = 0;
        if (hipGetDevice(&dev) != hipSuccess || hipDeviceGetAttribute(&cus, hipDeviceAttributeMultiprocessorCount, dev) != hipSuccess) { grid = -1; return; }
        if (hipFuncSetAttribute((const void*)fwd, hipFuncAttributeMaxDynamicSharedMemorySize, LDS_BYTES) != hipSuccess) { fprintf(stderr, "kernel_launch: hipFuncSetAttribute failed\n"); grid = -1; return; }
        if (hipOccupancyMaxActiveBlocksPerMultiprocessor(&per_cu, (const void*)fwd, NWAVES * 64, LDS_BYTES) != hipSuccess || per_cu < 1) { fprintf(stderr, "kernel_launch: occupancy query says %d\n", per_cu); }
        (void)hipGetLastError();
        grid = cus;
    }
    if (grid < 0) return;
    if (hipMemsetAsync((char*)d_ws + WS_CTL, 0, CTL_ZERO_BYTES, stream) != hipSuccess) return;
    Args a{};
    for (int i = 0; i < 22; ++i) a.in[i] = (const float*)d_in[i];
    a.out = (float*)d_out; a.ws = (unsigned char*)d_ws;
#if MK_PER_PHASE
    for (int p = 0; p < NPH; ++p) { a.ph_lo = p; a.ph_hi = p + 1; hipLaunchKernelGGL(fwd, dim3(grid), dim3(NWAVES * 64), LDS_BYTES, stream, a); }
#else
    a.ph_lo = 0; a.ph_hi = NPH; hipLaunchKernelGGL(fwd, dim3(grid), dim3(NWAVES * 64), LDS_BYTES, stream, a);
#endif
    const hipError_t le = hipPeekAtLastError();
    if (le != hipSuccess) fprintf(stderr, "kernel_launch: launch failed: %s\n", hipGetErrorName(le));
}
```
